# Optimizing an MI355X kernel written in HIP

```python
import math
import jax, jax.numpy as jnp
from jax import lax
import numpy as np

D_MODEL = 1024
BATCH = 32
SEQ = 256
DEPTH = 4
DEC_BATCH = 8
DEC_SEQ = 1024
PAST_LEN = 512

GRID_W = 64
N_PAIRS = DEPTH // 2
EPS = 1e-6
A_WIDTH = D_MODEL // 2
A_HEAD = 64
A_HEADS = A_WIDTH // A_HEAD
LORA_W = 64
LORA_A = 64
GN_EPS = 64e-5
B_WIDTH = D_MODEL // 2
CONV_W = 3
C_HEAD = 64
C_Q_HEADS = D_MODEL // C_HEAD
C_KV_HEADS = 4
C_GROUP = C_Q_HEADS // C_KV_HEADS
C_WIDTH = C_Q_HEADS * C_HEAD
KV_WIDTH = C_KV_HEADS * C_HEAD
Q_BLOCK = 128
ROPE_THETA = 10000.0
ROPE_HALF = C_HEAD // 2
A_SHIFT = 3 * A_WIDTH + 2 * LORA_W + 2 * LORA_A
EVEN_IN = A_SHIFT + A_WIDTH + 4 * B_WIDTH
ODD_IN = C_WIDTH + 2 * KV_WIDTH + C_WIDTH

kernel_name = 'hybrid_rwkv7_shortconv_gqa_diffusion_step'

f32 = jnp.float32


def rmsnorm(x, g):
    xf = x.astype(f32)
    y = xf * lax.rsqrt(jnp.mean(xf * xf, axis=-1, keepdims=True) + EPS)
    return (y * g.astype(f32)).astype(x.dtype)


def adaln(cond, w, b):
    return jax.nn.silu(cond) @ w + b


def modulate(x, g, mod):
    shift, scale, gate = jnp.split(mod, 3, axis=-1)
    h = rmsnorm(x, g) * (1 + scale[:, None]) + shift[:, None]
    return h, gate[:, None]


def _neighbours(f):
    zero = jnp.zeros_like(f[:, :1])
    prev = jnp.concatenate([zero, f[:, :-1]], axis=1)
    nxt = jnp.concatenate([f[:, 1:], zero], axis=1)
    return prev, nxt


def centred_shift(f, mu):
    prev, nxt = _neighbours(f)
    return f + mu * (0.5 * (prev + nxt) - f)


def centred_conv3(u, w, b):
    prev, nxt = _neighbours(u)
    return prev * w[0] + u * w[1] + nxt * w[2] + b


def rwkv_scan(S0, r, w, k, v, kk, a, reverse):
    def step(S, inp):
        r_t, w_t, k_t, v_t, kk_t, a_t = inp
        sk = jnp.einsum('bhvk,bhk->bhv', S, kk_t)
        S = (S * w_t[:, :, None, :] - sk[..., None] * (kk_t * a_t)[:, :, None, :]
             + v_t[..., None] * k_t[:, :, None, :])
        return S, jnp.einsum('bhvk,bhk->bhv', S, r_t)
    xs = tuple(jnp.moveaxis(t, 1, 0) for t in (r, w, k, v, kk, a))
    S, ys = lax.scan(step, S0, xs, reverse=reverse)
    return S, jnp.moveaxis(ys, 0, 1)


def rwkv_conv_mixer(h, S0, w_in, mu, lw2, w0, la2, a0, k_k, k_a, r_k, lnx_g, lnx_b,
                    conv_w, conv_b, w_out):
    B, L, _ = h.shape
    proj = h @ w_in
    feat = centred_shift(proj[..., :A_SHIFT], mu)
    r = feat[..., :A_WIDTH]
    k = feat[..., A_WIDTH:2 * A_WIDTH]
    v = feat[..., 2 * A_WIDTH:3 * A_WIDTH]
    o = 3 * A_WIDTH
    lw = feat[..., o:o + 2 * LORA_W].reshape(B, L, 2, LORA_W)
    o += 2 * LORA_W
    la = feat[..., o:o + 2 * LORA_A].reshape(B, L, 2, LORA_A)
    o = A_SHIFT
    g_a = proj[..., o:o + A_WIDTH]
    o += A_WIDTH
    bg = proj[..., o:o + B_WIDTH]
    cg = proj[..., o + B_WIDTH:o + 2 * B_WIDTH]
    xin = proj[..., o + 2 * B_WIDTH:o + 3 * B_WIDTH]
    g_b = proj[..., o + 3 * B_WIDTH:o + 4 * B_WIDTH]

    w_log = -jax.nn.softplus(-(w0 + jnp.einsum('bldr,drc->bldc', jnp.tanh(lw), lw2))) - 0.5
    decay = jnp.exp(-jnp.exp(w_log.astype(f32)))
    a = jax.nn.sigmoid(a0 + jnp.einsum('bldr,drc->bldc', la, la2))
    k_dir = k[:, :, None, :] * (1 + (a - 1) * k_a)

    heads = lambda t: t.reshape(t.shape[:-1] + (A_HEADS, A_HEAD)).astype(f32)
    r_h, v_h = heads(r), heads(v)
    kk = heads(k * k_k)
    kk = kk / jnp.maximum(jnp.sqrt(jnp.sum(kk * kk, axis=-1, keepdims=True)), 1e-12)
    w_h, a_h, k_h = heads(decay), heads(a), heads(k_dir)
    S0 = S0.astype(f32)
    S_f, y_f = rwkv_scan(S0[:, 0], r_h, w_h[:, :, 0], k_h[:, :, 0], v_h, kk, a_h[:, :, 0], False)
    S_b, y_b = rwkv_scan(S0[:, 1], r_h, w_h[:, :, 1], k_h[:, :, 1], v_h, kk, a_h[:, :, 1], True)
    y = y_f + y_b
    mean = jnp.mean(y, axis=-1, keepdims=True)
    var = jnp.mean(jnp.square(y - mean), axis=-1, keepdims=True)
    y = ((y - mean) * lax.rsqrt(var + GN_EPS)).reshape(B, L, A_WIDTH) * lnx_g + lnx_b
    bonus = jnp.sum(r_h * jnp.mean(k_h, axis=2) * r_k, axis=-1, keepdims=True) * v_h
    out_a = (y + bonus.reshape(B, L, A_WIDTH)).astype(h.dtype) * jax.nn.silu(g_a)

    out_b = bg * centred_conv3(cg * xin, conv_w, conv_b) * jax.nn.silu(g_b)
    out = jnp.concatenate([out_a, out_b], axis=-1) @ w_out
    return out, jnp.stack([S_f, S_b], axis=1)


def gqa_project(h, w_in, q_g, k_g):
    B, L, _ = h.shape
    proj = h @ w_in
    q = proj[..., :C_WIDTH].reshape(B, L, C_Q_HEADS, C_HEAD)
    k = proj[..., C_WIDTH:C_WIDTH + KV_WIDTH].reshape(B, L, C_KV_HEADS, C_HEAD)
    v = proj[..., C_WIDTH + KV_WIDTH:C_WIDTH + 2 * KV_WIDTH].reshape(B, L, C_KV_HEADS, C_HEAD)
    g = proj[..., C_WIDTH + 2 * KV_WIDTH:]
    return rmsnorm(q, q_g), rmsnorm(k, k_g), v, g


def axial_rope_tables(L):
    rows = L // GRID_W
    row = jnp.repeat(jnp.arange(rows, dtype=f32), GRID_W)
    col = (jnp.arange(L) % GRID_W).astype(f32)
    inv = ROPE_THETA ** (-jnp.arange(0, ROPE_HALF, 2, dtype=f32) / ROPE_HALF)
    ang_r = row[:, None, None] * inv
    ang_c = col[:, None, None] * inv
    return jnp.cos(ang_r), jnp.sin(ang_r), jnp.cos(ang_c), jnp.sin(ang_c)


def _rope_half(x, cos, sin):
    x1, x2 = jnp.split(x, 2, axis=-1)
    return jnp.concatenate([x1 * cos - x2 * sin, x2 * cos + x1 * sin], axis=-1)


def apply_axial_rope(x, tables):
    cos_r, sin_r, cos_c, sin_c = tables
    xf = x.astype(f32)
    out = jnp.concatenate([_rope_half(xf[..., :ROPE_HALF], cos_r, sin_r),
                           _rope_half(xf[..., ROPE_HALF:], cos_c, sin_c)], axis=-1)
    return out.astype(x.dtype)


def block_attention(q, k, v):
    B, L = q.shape[:2]
    nb = L // Q_BLOCK
    qb = q.reshape(B, nb, Q_BLOCK, C_KV_HEADS, C_GROUP, C_HEAD).swapaxes(0, 1)
    scale = C_HEAD ** -0.5

    def one(qblk):
        s = jnp.einsum('bqhgd,bhkd->bhgqk', qblk, k).astype(f32) * scale
        p = jax.nn.softmax(s, axis=-1).astype(v.dtype)
        return jnp.einsum('bhgqk,bhkd->bqhgd', p, v)

    out = lax.map(one, qb)
    return out.swapaxes(0, 1).reshape(B, L, C_WIDTH)


def setup_inputs(seed: int = 0) -> dict:
    key = jax.random.key(seed)
    ks = iter(jax.random.split(key, 40))
    nrm = lambda shape, s=1.0: s * jax.random.normal(next(ks), shape, f32)
    P = N_PAIRS
    return {
        'x_prompt': nrm((BATCH, SEQ, D_MODEL)),
        'x_sample': nrm((DEC_BATCH, DEC_SEQ, D_MODEL)),
        'c': nrm((DEC_BATCH, D_MODEL)),
        'state_rwkv': nrm((DEC_BATCH, P, 2, A_HEADS, A_HEAD, A_HEAD), 0.3),
        'cache_k': nrm((DEC_BATCH, P, C_KV_HEADS, PAST_LEN, C_HEAD)),
        'cache_v': nrm((DEC_BATCH, P, C_KV_HEADS, PAST_LEN, C_HEAD)),
        'c_ctx': nrm((D_MODEL,)),
        'w_ada': nrm((DEPTH, D_MODEL, 3 * D_MODEL), 0.5 * D_MODEL ** -0.5),
        'b_ada': nrm((DEPTH, 3 * D_MODEL), 0.02),
        'norm_g': 1.0 + nrm((DEPTH, D_MODEL), 0.02),
        'final_g': 1.0 + nrm((D_MODEL,), 0.02),
        'w_in_e': nrm((P, D_MODEL, EVEN_IN), D_MODEL ** -0.5),
        'mu_shift': jax.random.uniform(next(ks), (P, A_SHIFT), f32),
        'lora_w2': nrm((P, 2, LORA_W, A_WIDTH), 0.1 * LORA_W ** -0.5),
        'w0': jax.random.uniform(next(ks), (P, 2, A_WIDTH), f32, -6.0, 1.0),
        'lora_a2': nrm((P, 2, LORA_A, A_WIDTH), 0.1 * LORA_A ** -0.5),
        'a0': nrm((P, 2, A_WIDTH), 0.1),
        'k_k': 0.85 + nrm((P, A_WIDTH), 0.02),
        'k_a': 1.0 + nrm((P, A_WIDTH), 0.02),
        'r_k': nrm((P, A_HEADS, A_HEAD), 0.1),
        'lnx_g': 1.0 + nrm((P, A_WIDTH), 0.02),
        'lnx_b': nrm((P, A_WIDTH), 0.01),
        'conv_w': nrm((P, CONV_W, B_WIDTH), CONV_W ** -0.5),
        'conv_b': nrm((P, B_WIDTH), 0.01),
        'w_out_e': nrm((P, A_WIDTH + B_WIDTH, D_MODEL), (A_WIDTH + B_WIDTH) ** -0.5),
        'w_in_o': nrm((P, D_MODEL, ODD_IN), D_MODEL ** -0.5),
        'q_norm_g': 1.0 + nrm((P, C_HEAD), 0.02),
        'k_norm_g': 1.0 + nrm((P, C_HEAD), 0.02),
        'w_out_o': nrm((P, C_WIDTH, D_MODEL), C_WIDTH ** -0.5),
    }


def reference(x_prompt, x_sample, c, state_rwkv, cache_k, cache_v, c_ctx, w_ada, b_ada,
              norm_g, final_g, w_in_e, mu_shift, lora_w2, w0, lora_a2, a0, k_k, k_a, r_k,
              lnx_g, lnx_b, conv_w, conv_b, w_out_e, w_in_o, q_norm_g, k_norm_g, w_out_o):
    xp, xs = x_prompt, x_sample
    rope = axial_rope_tables(xs.shape[1])
    zero_state = jnp.zeros((xp.shape[0], 2, A_HEADS, A_HEAD, A_HEAD), f32)
    new_rwkv, new_k, new_v = [], [], []
    for layer in range(DEPTH):
        p = layer // 2
        mod_p = adaln(c_ctx[None, :], w_ada[layer], b_ada[layer])
        mod_s = adaln(c, w_ada[layer], b_ada[layer])
        hp, gate_p = modulate(xp, norm_g[layer], mod_p)
        hs, gate_s = modulate(xs, norm_g[layer], mod_s)
        if layer % 2 == 0:
            ew = (w_in_e[p], mu_shift[p], lora_w2[p], w0[p], lora_a2[p], a0[p], k_k[p],
                  k_a[p], r_k[p], lnx_g[p], lnx_b[p], conv_w[p], conv_b[p], w_out_e[p])
            out_p, st_p = rwkv_conv_mixer(hp, zero_state, *ew)
            out_s, _ = rwkv_conv_mixer(hs, state_rwkv[:, p], *ew)
            new_rwkv.append(st_p)
        else:
            qp, kp, vp, gp = gqa_project(hp, w_in_o[p], q_norm_g[p], k_norm_g[p])
            kp_t, vp_t = kp.transpose(0, 2, 1, 3), vp.transpose(0, 2, 1, 3)
            out_p = (block_attention(qp, kp_t, vp_t) * jax.nn.silu(gp)) @ w_out_o[p]
            qs, ks_, vs, gs = gqa_project(hs, w_in_o[p], q_norm_g[p], k_norm_g[p])
            qs = apply_axial_rope(qs, rope)
            ks_ = apply_axial_rope(ks_, rope)
            keys = jnp.concatenate([cache_k[:, p], ks_.transpose(0, 2, 1, 3)], axis=2)
            vals = jnp.concatenate([cache_v[:, p], vs.transpose(0, 2, 1, 3)], axis=2)
            out_s = (block_attention(qs, keys, vals) * jax.nn.silu(gs)) @ w_out_o[p]
            new_k.append(kp_t)
            new_v.append(vp_t)
        xp = xp + gate_p * out_p
        xs = xs + gate_s * out_s
    y_prompt = rmsnorm(xp, final_g)
    y_sample = rmsnorm(xs, final_g)
    new_state_rwkv = jnp.stack(new_rwkv, axis=1)
    new_cache_k = jnp.stack(new_k, axis=1)
    new_cache_v = jnp.stack(new_v, axis=1)
    return (y_prompt, y_sample, new_state_rwkv, new_cache_k, new_cache_v)
```

```cpp
#include <hip/hip_runtime.h>
#include <hip/hip_cooperative_groups.h>
#include <cstdio>
namespace cg = cooperative_groups;

#define LAS __attribute__((address_space(3)))
typedef unsigned short bf16_t;
typedef short bf16x8 __attribute__((ext_vector_type(8)));
typedef float f32x4 __attribute__((ext_vector_type(4)));
typedef float f32x2 __attribute__((ext_vector_type(2)));
typedef unsigned u32x4 __attribute__((ext_vector_type(4)));
typedef unsigned u32x2 __attribute__((ext_vector_type(2)));

constexpr int DM = 1024, NTOK = 16384, NPR = 8192;
constexpr int EVEN_IN = 4352, ODD_IN = 2560;
constexpr int NTHREADS = 512;
constexpr int LDS_BYTES = 131072 + 16;
constexpr size_t OUT_Y = 0, OUT_STATE = 2ull * 8388608, OUT_CK = OUT_STATE + 4194304, OUT_CV = OUT_CK + 4194304;

constexpr size_t WS_WINE = 0;
constexpr size_t WS_WOUTE = WS_WINE + 2ull * EVEN_IN * 1024 * 2;
constexpr size_t WS_WINO = WS_WOUTE + 2ull * 1024 * 1024 * 2;
constexpr size_t WS_WOUTO = WS_WINO + 2ull * ODD_IN * 1024 * 2;
constexpr size_t WS_MOD = WS_WOUTO + 2ull * 1024 * 1024 * 2;
constexpr size_t WS_ROPE = WS_MOD + 4ull * 9 * 3072 * 4;
constexpr size_t WS_BS = WS_ROPE + 16384;
constexpr size_t WS_HMIX = WS_BS + 2ull * NTOK * 8 * 4;
constexpr size_t WS_PROJ = WS_HMIX + (size_t)NTOK * 1024 * 2;
constexpr size_t WS_Y = WS_PROJ + (size_t)NTOK * EVEN_IN * 2;
constexpr size_t WS_BAR = WS_Y + 2ull * NTOK * 512 * 2;
constexpr size_t WS_XCNT = WS_BAR + 16384;
constexpr size_t WS_XSLOT = WS_XCNT + 4ull * 64 * 256;
constexpr size_t WS_END = WS_XSLOT + 64ull * 256 * 4 * 4;

struct Params {
    const float* x_prompt; const float* x_sample; const float* c; const float* state_rwkv; const float* cache_k; const float* cache_v;
    const float* c_ctx; const float* w_ada; const float* b_ada; const float* norm_g; const float* final_g; const float* w_in_e;
    const float* mu_shift; const float* lora_w2; const float* w0; const float* lora_a2; const float* a0; const float* k_k; const float* k_a;
    const float* r_k; const float* lnx_g; const float* lnx_b; const float* conv_w; const float* conv_b; const float* w_out_e;
    const float* w_in_o; const float* q_norm_g; const float* k_norm_g; const float* w_out_o;
    float* out; unsigned char* ws;
};

__device__ __forceinline__ float bf2f(unsigned v) { return __uint_as_float(v << 16); }
__device__ __forceinline__ float bflo(unsigned v) { return __uint_as_float(v << 16); }
__device__ __forceinline__ float bfhi(unsigned v) { return __uint_as_float(v & 0xffff0000u); }
__device__ __forceinline__ unsigned cvt_pk_bf16(float lo, float hi) { unsigned r; asm volatile("v_cvt_pk_bf16_f32 %0, %1, %2" : "=v"(r) : "v"(lo), "v"(hi)); return r; }
__device__ __forceinline__ float sigmoidf_(float x) { return __builtin_amdgcn_rcpf(1.0f + __expf(-x)); }
__device__ __forceinline__ float tanhf_(float x) { return 2.0f * __builtin_amdgcn_rcpf(1.0f + __expf(-2.0f * x)) - 1.0f; }
__device__ __forceinline__ float siluf_(float x) { return x * __builtin_amdgcn_rcpf(1.0f + __expf(-x)); }
__device__ __forceinline__ int otid() { int t = threadIdx.x; asm volatile("" : "+v"(t)); return t; }
template <int CTRL> __device__ __forceinline__ float dpp_add(float x) {
    return x + __builtin_bit_cast(float, __builtin_amdgcn_update_dpp(0, __builtin_bit_cast(int, x), CTRL, 0xf, 0xf, true));
}
__device__ __forceinline__ float allred4(float x) { x = dpp_add<0xB1>(x); x = dpp_add<0x4E>(x); return x; }
__device__ __forceinline__ float allred8(float x) { x = dpp_add<0x141>(x); x = dpp_add<0xB1>(x); x = dpp_add<0x4E>(x); return x; }
__device__ __forceinline__ float allred16(float x) { x = allred8(x); x = dpp_add<0x128>(x); return x; }
__device__ __forceinline__ float allred64(float x) { x = allred16(x); x += __shfl_xor(x, 16); x += __shfl_xor(x, 32); return x; }

#define XB_TMO      128
#define XB_XCNT(j)  (256  + 64 * (j))
#define XB_XSUB(j)  (1280 + 64 * (j))
#define XB_XGEN(j)  (2304 + 64 * (j))
#define XB_TOP      3328
#define XB_TOPGEN   3392
#define XCD_BAR_WORDS 3456
#define XB_SPIN_CAP (1u << 22)
__device__ __forceinline__ unsigned xb_ld(unsigned* p)              { return __hip_atomic_load(p, __ATOMIC_RELAXED, __HIP_MEMORY_SCOPE_AGENT); }
__device__ __forceinline__ unsigned xb_add(unsigned* p, unsigned v) { return __hip_atomic_fetch_add(p, v, __ATOMIC_RELAXED, __HIP_MEMORY_SCOPE_AGENT); }
__device__ __forceinline__ unsigned xb_xcc_id() { return (unsigned)__builtin_amdgcn_s_getreg((3 << 11) | 20) & 0xFu; }
#define XB_SPIN(cond, bar) do { unsigned _sp = 0; while (cond) { __builtin_amdgcn_s_sleep(1); \
    if ((++_sp & 255u) == 0u) { if (xb_ld(&(bar)[XB_TMO])) break; if (_sp > XB_SPIN_CAP) { atomicAdd(&(bar)[XB_TMO], 1u); break; } } } } while (0)
struct XcdBarrier { unsigned* bar; unsigned x; volatile LAS unsigned* st; };
__device__ __forceinline__ XcdBarrier xcd_barrier_post(unsigned* bar, volatile LAS unsigned* st) {
    XcdBarrier b; b.bar = bar; b.x = xb_xcc_id(); b.st = st;
    if (threadIdx.x == 0) (void)xb_add(&bar[XB_XCNT(b.x)], 1u);
    return b;
}
__device__ __forceinline__ void xcd_barrier_complete(unsigned* bar, unsigned x, unsigned& nloc, unsigned& nx) {
    const unsigned G = gridDim.x * gridDim.y * gridDim.z;
    unsigned sum, cnt, mine, sp = 0u;
    for (;;) {
        sum = 0u; cnt = 0u; mine = 0u;
#pragma unroll
        for (unsigned j = 0; j < 16; ++j) { const unsigned c = xb_ld(&bar[XB_XCNT(j)]); sum += c; cnt += (c > 0u) ? 1u : 0u; mine = (j == x) ? c : mine; }
        if (sum == G) break;
        __builtin_amdgcn_s_sleep(1);
        if ((++sp & 255u) == 0u) { if (xb_ld(&bar[XB_TMO])) break; if (sp > XB_SPIN_CAP) { atomicAdd(&bar[XB_TMO], 1u); break; } }
    }
    nloc = mine > 0u ? mine : 1u; nx = cnt > 0u ? cnt : 1u;
}
__device__ __forceinline__ void xcd_barrier(const XcdBarrier& b) {
    asm volatile("s_waitcnt vmcnt(0)" ::: "memory");
    __syncthreads();
    if (threadIdx.x == 0) {
        unsigned* bar = b.bar;
        __builtin_amdgcn_s_waitcnt(0);
        unsigned nloc = b.st[0], nx = b.st[1];
        if (nloc == 0u) { xcd_barrier_complete(bar, b.x, nloc, nx); b.st[0] = nloc; b.st[1] = nx; }
        const unsigned old = xb_add(&bar[XB_XSUB(b.x)], 1u);
        const unsigned gen = old / nloc;
        if (old + 1u == (gen + 1u) * nloc) {
            __builtin_amdgcn_fence(__ATOMIC_RELEASE, "agent");
            asm volatile("s_waitcnt vmcnt(0)" ::: "memory");
            const unsigned og = xb_add(&bar[XB_TOP], 1u);
            const unsigned tg = og / nx;
            if (og + 1u == (tg + 1u) * nx) xb_add(&bar[XB_TOPGEN], 1u);
            else XB_SPIN(xb_ld(&bar[XB_TOPGEN]) == tg, bar);
            __builtin_amdgcn_fence(__ATOMIC_ACQUIRE, "agent");
            xb_add(&bar[XB_XGEN(b.x)], 1u);
            asm volatile("s_waitcnt vmcnt(0)" ::: "memory");
        } else {
            XB_SPIN(xb_ld(&bar[XB_XGEN(b.x)]) == gen, bar);
            __builtin_amdgcn_fence(__ATOMIC_ACQUIRE, "agent");
            asm volatile("s_waitcnt vmcnt(0)" ::: "memory");
        }
    }
    __syncthreads();
}

namespace pg8 {
constexpr int BM = 256, BK = 64, HALF = 128, HTB = HALF * BK * 2, NXCD = 8, WGM = 8;
__device__ __forceinline__ int lds_byte(int r, int c) { const int st = (r >> 4) * 2 + (c >> 5), rr = r & 15, cc = c & 31, ob = rr * 64 + cc * 2; return st * 1024 + (ob ^ (((ob >> 9) & 1) << 5)); }
__device__ __forceinline__ void stage_rc(int b, int& R, int& C) { const int st = b / 1024, sb = b % 1024, swz = sb ^ (((sb >> 9) & 1) << 5); R = (st >> 1) * 16 + swz / 64; C = (st & 1) * 32 + (swz % 64) / 2; }
__device__ __forceinline__ int perm32(int rho) { const int n = rho >> 4, i = rho & 15; return 8 * (i >> 2) + 4 * n + (i & 3); }
struct Unit { int pm, pn; };
struct Gemm { const bf16_t* A; const bf16_t* Bt; int M, N, K; };
struct StaticOrder {
    int nM, nN, nwg, G, c;
    __device__ void init(int M, int N, int G_, int c_) { nM = M / BM; nN = N / BM; nwg = nM * nN; G = G_; c = c_; }
    __device__ bool next(int i, Unit& u) const {
        const long L = (long)i * G + c; if (L >= nwg) return false;
        int wgid = (int)L; { const int q = nwg / NXCD, r = nwg % NXCD, xcd = wgid % NXCD, off = wgid / NXCD; wgid = (xcd < r ? xcd * (q + 1) : r * (q + 1) + (xcd - r) * q) + off; }
        const int nig = WGM * nN, gid = wgid / nig, fm = gid * WGM, gsz = (nM - fm) < WGM ? (nM - fm) : WGM;
        u.pm = fm + ((wgid % nig) % gsz); u.pn = (wgid % nig) / gsz; return true;
    }
};
struct EpiBf16 {
    static constexpr bool PERM = true, AFTER_DRAIN = false;
    bf16_t* O; int ldc;
    __device__ __forceinline__ void operator()(const f32x4 (&acc)[2][2][4][2], const Unit& u, int wr, int wc, int fr, int fq) const {
        const int row0 = u.pm * BM + wr * 64 + fr; const int col0 = u.pn * BM + wc * 32 + 8 * fq;
#pragma unroll
        for (int ai = 0; ai < 2; ++ai)
#pragma unroll
            for (int m = 0; m < 4; ++m) { bf16_t* rowp = O + (size_t)(row0 + ai * HALF + m * 16) * ldc + col0;
#pragma unroll
                for (int bj = 0; bj < 2; ++bj) { const f32x4 v0 = acc[ai][bj][m][0], v1 = acc[ai][bj][m][1];
                    u32x4 w; w.x = cvt_pk_bf16(v0[0], v0[1]); w.y = cvt_pk_bf16(v0[2], v0[3]); w.z = cvt_pk_bf16(v1[0], v1[1]); w.w = cvt_pk_bf16(v1[2], v1[3]);
                    *(u32x4*)(rowp + bj * HALF) = w; } }
    }
};
struct EpiResGate {
    static constexpr bool PERM = false, AFTER_DRAIN = false;
    const float* xp; const float* xs; float* xo; const float* modl;
    __device__ __forceinline__ void operator()(const f32x4 (&acc)[2][2][4][2], const Unit& u, int wr, int wc, int fr, int fq) const {
        const int row0 = u.pm * BM + wr * 64 + fr, col0 = u.pn * BM + wc * 32 + 4 * fq;
        const int mi = (u.pm < 32) ? 0 : 1 + ((u.pm - 32) >> 2);
        const float* gp = modl + mi * 3072 + 2048 + col0;
        f32x4 gv[2][2];
#pragma unroll
        for (int bj = 0; bj < 2; ++bj)
#pragma unroll
            for (int n = 0; n < 2; ++n) gv[bj][n] = *(const f32x4*)(gp + bj * HALF + n * 16);
#pragma unroll
        for (int ai = 0; ai < 2; ++ai)
#pragma unroll
            for (int m = 0; m < 4; ++m) { const int row = row0 + ai * HALF + m * 16;
                const float* src = (row < NPR ? xp + (size_t)row * DM : xs + (size_t)(row - NPR) * DM) + col0; float* dst = xo + (size_t)row * DM + col0;
                f32x4 xv[2][2];
#pragma unroll
                for (int bj = 0; bj < 2; ++bj)
#pragma unroll
                    for (int n = 0; n < 2; ++n) xv[bj][n] = *(const f32x4*)(src + bj * HALF + n * 16);
#pragma unroll
                for (int bj = 0; bj < 2; ++bj)
#pragma unroll
                    for (int n = 0; n < 2; ++n) *(f32x4*)(dst + bj * HALF + n * 16) = xv[bj][n] + gv[bj][n] * acc[ai][bj][m][n]; }
    }
};

struct EpiFuse {
    static constexpr bool PERM = true, AFTER_DRAIN = true;
    const float* xp; const float* xs; float* xo; const float* modl;
    bf16_t* hout; const float* gn; const float* modn;
    const float* fing;
    float* xslots; unsigned* cnt;
    __device__ __forceinline__ void fused(f32x4 (&acc)[2][2][4][2], const Unit& u, int wr, int wc, int fr, int fq, LAS unsigned char* lds, int wid, int lane) const {
        const int tid = wid * 64 + lane;
        const int row0 = u.pm * BM + wr * 64 + fr, col0 = u.pn * BM + wc * 32 + 8 * fq;
        const int mi = (u.pm < 32) ? 0 : 1 + ((u.pm - 32) >> 2);
        LAS float* Pt = (LAS float*)lds;
        LAS float* St = (LAS float*)(lds + 4096);
        {
            const float* gp = modl + mi * 3072 + 2048 + col0;
            f32x4 gv[2][2];
#pragma unroll
            for (int bj = 0; bj < 2; ++bj)
#pragma unroll
                for (int n = 0; n < 2; ++n) gv[bj][n] = *(const f32x4*)(gp + bj * HALF + n * 4);
#pragma unroll
            for (int ai = 0; ai < 2; ++ai)
#pragma unroll
                for (int m = 0; m < 4; ++m) { const int row = row0 + ai * HALF + m * 16;
                    const float* src = (row < NPR ? xp + (size_t)row * DM : xs + (size_t)(row - NPR) * DM) + col0;
                    float ss = 0.f;
#pragma unroll
                    for (int bj = 0; bj < 2; ++bj)
#pragma unroll
                        for (int n = 0; n < 2; ++n) { const f32x4 xn = *(const f32x4*)(src + bj * HALF + n * 4) + gv[bj][n] * acc[ai][bj][m][n]; acc[ai][bj][m][n] = xn;
                            ss += xn[0] * xn[0] + xn[1] * xn[1] + xn[2] * xn[2] + xn[3] * xn[3]; }
                    ss += __shfl_xor(ss, 16); ss += __shfl_xor(ss, 32);
                    if (fq == 0) Pt[(ai * HALF + wr * 64 + m * 16 + fr) * 4 + wc] = ss; }
        }
        asm volatile("s_waitcnt lgkmcnt(0)" ::: "memory"); __builtin_amdgcn_s_barrier(); asm volatile("" ::: "memory");
        if (tid < 256) { const f32x4 p4 = *(const LAS f32x4*)(Pt + tid * 4);
            __hip_atomic_store(xslots + ((size_t)u.pm * 256 + tid) * 4 + u.pn, (p4[0] + p4[1]) + (p4[2] + p4[3]), __ATOMIC_RELAXED, __HIP_MEMORY_SCOPE_AGENT); }
        asm volatile("s_waitcnt vmcnt(0)" ::: "memory");
        if (tid < 256 && lane == 0) __hip_atomic_fetch_add(cnt + 64 * u.pm, 1u, __ATOMIC_RELAXED, __HIP_MEMORY_SCOPE_AGENT);
        if (wid == 0) { unsigned sp = 0;
            while ((unsigned)__builtin_amdgcn_readfirstlane(__hip_atomic_load(cnt + 64 * u.pm, __ATOMIC_RELAXED, __HIP_MEMORY_SCOPE_AGENT)) < 16u) { __builtin_amdgcn_s_sleep(1); if (++sp > (1u << 24)) break; }
            __builtin_amdgcn_fence(__ATOMIC_ACQUIRE, "agent"); }
        asm volatile("s_waitcnt vmcnt(0) lgkmcnt(0)" ::: "memory"); __builtin_amdgcn_s_barrier(); asm volatile("" ::: "memory");
        if (tid < 256) { const float* sl = xslots + ((size_t)u.pm * 256 + tid) * 4; float tot = 0.f;
#pragma unroll
            for (int t = 0; t < 4; ++t) tot += __hip_atomic_load(sl + t, __ATOMIC_RELAXED, __HIP_MEMORY_SCOPE_AGENT);
            St[tid] = rsqrtf(tot * (1.0f / 1024.0f) + 1e-6f); }
        asm volatile("s_waitcnt lgkmcnt(0)" ::: "memory"); __builtin_amdgcn_s_barrier(); asm volatile("" ::: "memory");
        f32x4 cs[2][2], sh[2][2];
#pragma unroll
        for (int bj = 0; bj < 2; ++bj)
#pragma unroll
            for (int n = 0; n < 2; ++n) { const int c = col0 + bj * HALF + n * 4;
                if (hout) { cs[bj][n] = *(const f32x4*)(gn + c) * (*(const f32x4*)(modn + mi * 3072 + 1024 + c) + 1.0f); sh[bj][n] = *(const f32x4*)(modn + mi * 3072 + c); }
                else { cs[bj][n] = *(const f32x4*)(fing + c); sh[bj][n] = (f32x4){0.f, 0.f, 0.f, 0.f}; } }
#pragma unroll
        for (int ai = 0; ai < 2; ++ai)
#pragma unroll
            for (int m = 0; m < 4; ++m) { const int rl = ai * HALF + wr * 64 + m * 16 + fr; const int row = u.pm * BM + rl; const float rs = St[rl];
                float* dst = xo + (size_t)row * DM + col0;
#pragma unroll
                for (int bj = 0; bj < 2; ++bj) { const f32x4 x0 = acc[ai][bj][m][0], x1 = acc[ai][bj][m][1]; const f32x4 h0 = x0 * rs * cs[bj][0] + sh[bj][0], h1 = x1 * rs * cs[bj][1] + sh[bj][1];
                    if (hout) { *(f32x4*)(dst + bj * HALF) = x0; *(f32x4*)(dst + bj * HALF + 4) = x1;
                        u32x4 w; w.x = cvt_pk_bf16(h0[0], h0[1]); w.y = cvt_pk_bf16(h0[2], h0[3]); w.z = cvt_pk_bf16(h1[0], h1[1]); w.w = cvt_pk_bf16(h1[2], h1[3]); *(u32x4*)(hout + (size_t)row * DM + col0 + bj * HALF) = w; }
                    else { *(f32x4*)(dst + bj * HALF) = h0; *(f32x4*)(dst + bj * HALF + 4) = h1; } } }
    }
};

template <class Epi>
__device__ __forceinline__ void gemm_phase(LAS unsigned char* lds, const Gemm g, const StaticOrder& S, const Epi& E) {
    const int tid = otid(), wid = __builtin_amdgcn_readfirstlane(tid >> 6), lane = tid & 63, wr = wid >> 2, wc = wid & 3, fr = lane & 15, fq = lane >> 4;
    const int K = g.K, nt = K / BK;
    unsigned voffA[2], voffB[2];
#pragma unroll
    for (int i = 0; i < 2; ++i) { int R, C; stage_rc(tid * 16 + i * 8192, R, C); const int Rb = Epi::PERM ? ((R & ~31) + perm32(R & 31)) : R;
        voffA[i] = (unsigned)(R * K + C) * 2u; voffB[i] = (unsigned)(Rb * K + C) * 2u; }
    const size_t kstep = (size_t)(BK * 2);
    const size_t hstep = (size_t)HALF * K * 2;
    const size_t tstep = 2 * hstep;
    const unsigned ldsw = (unsigned)wid * 1024u;
    const int aoff = lds_byte(wr * 64 + fr, fq * 8), boff = lds_byte(wc * 32 + fr, fq * 8);
#define PG8_SA(b, h) (((b) * 2 + (h)) * HTB)
#define PG8_SB(b, h) ((4 + (b) * 2 + (h)) * HTB)
#define PG8_STAGE(bufoff, gbase, voff) do { _Pragma("unroll") for (int _i = 0; _i < 2; ++_i) \
        __builtin_amdgcn_global_load_lds((const unsigned*)((const char*)(gbase) + (voff)[_i]), (LAS unsigned*)(lds + (bufoff) + ldsw + _i * 8192), 16, 0, 0); } while (0)
#define PG8_LDA(dst, b, h) do { _Pragma("unroll") for (int m = 0; m < 4; ++m) _Pragma("unroll") for (int k = 0; k < 2; ++k) dst[m][k] = *(const LAS bf16x8*)(lds + PG8_SA(b, h) + aoff + m * 2048 + k * 1024); } while (0)
#define PG8_LDB(dst, b, h) do { _Pragma("unroll") for (int n = 0; n < 2; ++n) _Pragma("unroll") for (int k = 0; k < 2; ++k) dst[n][k] = *(const LAS bf16x8*)(lds + PG8_SB(b, h) + boff + n * 2048 + k * 1024); } while (0)
#define PG8_MMA(ai, bj, At, Bt) do { __builtin_amdgcn_s_setprio(1); _Pragma("unroll") for (int m = 0; m < 4; ++m) _Pragma("unroll") for (int n = 0; n < 2; ++n) _Pragma("unroll") for (int k = 0; k < 2; ++k) \
        acc[ai][bj][m][n] = __builtin_amdgcn_mfma_f32_16x16x32_bf16(Bt[n][k], At[m][k], acc[ai][bj][m][n], 0, 0, 0); __builtin_amdgcn_s_setprio(0); } while (0)
#define PG8_WAIT_V(n) asm volatile("s_waitcnt vmcnt(" #n ")" ::: "memory")
#define PG8_WAIT_L(n) asm volatile("s_waitcnt lgkmcnt(" #n ")" ::: "memory")
#define PG8_BAR __builtin_amdgcn_s_barrier()
#define PG8_SCHED __builtin_amdgcn_sched_barrier(0)
    Unit cur, nxt; int ui = 0;
    if (!S.next(0, cur)) return;
    f32x4 acc[2][2][4][2];
#pragma unroll
    for (int a = 0; a < 2; ++a)
#pragma unroll
        for (int b = 0; b < 2; ++b)
#pragma unroll
            for (int m = 0; m < 4; ++m)
#pragma unroll
                for (int n = 0; n < 2; ++n) acc[a][b][m][n] = (f32x4){0.f, 0.f, 0.f, 0.f};
    bf16x8 At[4][2], B0[2][2], B1[2][2];
    const char* cA = (const char*)g.A + (size_t)cur.pm * tstep; const char* cB = (const char*)g.Bt + (size_t)cur.pn * tstep;
    PG8_STAGE(PG8_SB(0, 0), cB, voffB); PG8_STAGE(PG8_SA(0, 0), cA, voffA); PG8_STAGE(PG8_SB(0, 1), cB + hstep, voffB); PG8_STAGE(PG8_SA(0, 1), cA + hstep, voffA);
    if (wr == 1) PG8_BAR;
    PG8_WAIT_V(4); PG8_BAR;
    PG8_STAGE(PG8_SB(1, 0), cB + kstep, voffB); PG8_STAGE(PG8_SA(1, 0), cA + kstep, voffA); PG8_STAGE(PG8_SB(1, 1), cB + hstep + kstep, voffB);
    PG8_WAIT_V(6); PG8_BAR;
    for (;;) {
        const bool has_next = S.next(ui + 1, nxt);
        const char* nA = has_next ? (const char*)g.A + (size_t)nxt.pm * tstep : cA; const char* nB = has_next ? (const char*)g.Bt + (size_t)nxt.pn * tstep : cB;
        for (int t = 0; t < nt; t += 2) {
            const bool last = (t == nt - 2);
            const char* a1 = cA + (size_t)(t + 1) * kstep;
            const char* a2 = last ? nA : cA + (size_t)(t + 2) * kstep; const char* b2 = last ? nB : cB + (size_t)(t + 2) * kstep;
            const char* a3 = a2 + kstep; const char* b3 = b2 + kstep;
            PG8_LDB(B0, 0, 0); PG8_SCHED; PG8_LDA(At, 0, 0); PG8_STAGE(PG8_SA(1, 1), a1 + hstep, voffA);
            PG8_WAIT_L(8); PG8_BAR; PG8_WAIT_L(0); PG8_MMA(0, 0, At, B0); PG8_BAR; PG8_SCHED;
            PG8_LDB(B1, 0, 1); PG8_STAGE(PG8_SB(0, 0), b2, voffB);
            PG8_BAR; PG8_WAIT_L(0); PG8_MMA(0, 1, At, B1); PG8_BAR;
            PG8_LDA(At, 0, 1); PG8_STAGE(PG8_SA(0, 0), a2, voffA);
            PG8_BAR; PG8_WAIT_L(0); PG8_MMA(1, 0, At, B0); PG8_BAR; PG8_SCHED;
            PG8_STAGE(PG8_SB(0, 1), b2 + hstep, voffB);
            PG8_WAIT_V(6); PG8_BAR; PG8_MMA(1, 1, At, B1); PG8_BAR;
            PG8_LDB(B0, 1, 0); PG8_SCHED; PG8_LDA(At, 1, 0); PG8_STAGE(PG8_SA(0, 1), a2 + hstep, voffA);
            PG8_WAIT_L(8); PG8_BAR; PG8_WAIT_L(0); PG8_MMA(0, 0, At, B0); PG8_BAR; PG8_SCHED;
            PG8_LDB(B1, 1, 1); PG8_STAGE(PG8_SB(1, 0), b3, voffB);
            PG8_BAR; PG8_WAIT_L(0); PG8_MMA(0, 1, At, B1); PG8_BAR;
            PG8_LDA(At, 1, 1); PG8_STAGE(PG8_SA(1, 0), a3, voffA);
            PG8_BAR; PG8_WAIT_L(0); PG8_MMA(1, 0, At, B0); PG8_BAR; PG8_SCHED;
            PG8_STAGE(PG8_SB(1, 1), b3 + hstep, voffB);
            PG8_WAIT_V(6); PG8_BAR; PG8_MMA(1, 1, At, B1); PG8_BAR;
        }
        if constexpr (!Epi::AFTER_DRAIN) E(acc, cur, wr, wc, fr, fq);
        if (!has_next) break;
#pragma unroll
        for (int a = 0; a < 2; ++a)
#pragma unroll
            for (int b = 0; b < 2; ++b)
#pragma unroll
                for (int m = 0; m < 4; ++m)
#pragma unroll
                    for (int n = 0; n < 2; ++n) acc[a][b][m][n] = (f32x4){0.f, 0.f, 0.f, 0.f};
        cur = nxt; cA = nA; cB = nB; ++ui;
    }
    PG8_WAIT_V(0);
    if (wr == 0) PG8_BAR;
    PG8_BAR;
    if constexpr (Epi::AFTER_DRAIN) E.fused(acc, cur, wr, wc, fr, fq, lds, wid, lane);
#undef PG8_SA
#undef PG8_SB
#undef PG8_STAGE
#undef PG8_LDA
#undef PG8_LDB
#undef PG8_MMA
#undef PG8_WAIT_V
#undef PG8_WAIT_L
#undef PG8_BAR
#undef PG8_SCHED
}
}

__device__ __forceinline__ void p0_transpose_tile(const float* __restrict__ src, int N, bf16_t* __restrict__ dst, int tile, LAS float* tl) {
    const int tid = otid(); const int ntn = N >> 6; const int nt = tile % ntn, kt = tile / ntn; const int n0 = nt * 64, k0 = kt * 64;
#pragma unroll
    for (int it = 0; it < 2; ++it) { const int row = (tid >> 4) + 32 * it, c4 = (tid & 15) * 4;
        const f32x4 v = *(const f32x4*)(src + (size_t)(k0 + row) * N + n0 + c4);
        tl[row * 65 + c4 + 0] = v[0]; tl[row * 65 + c4 + 1] = v[1]; tl[row * 65 + c4 + 2] = v[2]; tl[row * 65 + c4 + 3] = v[3]; }
    __syncthreads();
    { const int n = tid >> 3, ks = tid & 7; float f[8];
#pragma unroll
      for (int j = 0; j < 8; ++j) f[j] = tl[(ks * 8 + j) * 65 + n];
      u32x4 w; w.x = cvt_pk_bf16(f[0], f[1]); w.y = cvt_pk_bf16(f[2], f[3]); w.z = cvt_pk_bf16(f[4], f[5]); w.w = cvt_pk_bf16(f[6], f[7]);
      *(u32x4*)(dst + (size_t)(n0 + n) * 1024 + k0 + ks * 8) = w; }
    __syncthreads();
}

__device__ void tr_range(const Params& P, LAS unsigned char* lds, int t_begin, int t_end, int start, int stride) {
    LAS float* tl = (LAS float*)lds;
    constexpr int T0 = 2 * (EVEN_IN / 64) * 16, T1 = 2 * 16 * 16, T2 = 2 * (ODD_IN / 64) * 16;
    for (int t = t_begin + start; t < t_end; t += stride) {
        const float* src; bf16_t* dst; int N, tt;
        if (t < T0) { const int per = T0 / 2, p = t / per; tt = t % per; N = EVEN_IN; src = P.w_in_e + (size_t)p * 1024 * EVEN_IN; dst = (bf16_t*)(P.ws + WS_WINE) + (size_t)p * EVEN_IN * 1024; }
        else if (t < T0 + T1) { const int u = t - T0, per = T1 / 2, p = u / per; tt = u % per; N = 1024; src = P.w_out_e + (size_t)p * 1024 * 1024; dst = (bf16_t*)(P.ws + WS_WOUTE) + (size_t)p * 1024 * 1024; }
        else if (t < T0 + T1 + T2) { const int u = t - T0 - T1, per = T2 / 2, p = u / per; tt = u % per; N = ODD_IN; src = P.w_in_o + (size_t)p * 1024 * ODD_IN; dst = (bf16_t*)(P.ws + WS_WINO) + (size_t)p * ODD_IN * 1024; }
        else { const int u = t - T0 - T1 - T2, per = 256, p = u / per; tt = u % per; N = 1024; src = P.w_out_o + (size_t)p * 1024 * 1024; dst = (bf16_t*)(P.ws + WS_WOUTO) + (size_t)p * 1024 * 1024; }
        p0_transpose_tile(src, N, dst, tt, tl);
    }
}

__device__ void p0_phase(const Params& P, LAS unsigned char* lds) {
    const int tid = otid(), bid = blockIdx.x, G = gridDim.x;
    if (bid < 192) {
        LAS float* s = (LAS float*)lds;
        LAS float* red = (LAS float*)(lds + 9 * 1024 * 4);
        for (int i = tid; i < 9 * 1024; i += NTHREADS) { const int ci = i >> 10, k = i & 1023; const float v = ci == 0 ? P.c_ctx[k] : P.c[(ci - 1) * 1024 + k]; s[i] = siluf_(v); }
        __syncthreads();
        const int L = bid / 48, jb = bid % 48; const int kg = tid >> 6, col = tid & 63;
        const float* w = P.w_ada + (size_t)L * 1024 * 3072 + (size_t)(kg * 128) * 3072 + jb * 64 + col;
        float acc[9];
#pragma unroll
        for (int i = 0; i < 9; ++i) acc[i] = 0.f;
        for (int k = 0; k < 128; k += 4) {
            float wv[4];
#pragma unroll
            for (int kk = 0; kk < 4; ++kk) wv[kk] = w[(size_t)(k + kk) * 3072];
#pragma unroll
            for (int i = 0; i < 9; ++i) { const f32x4 sv = *(const LAS f32x4*)(s + i * 1024 + kg * 128 + k); acc[i] += sv[0] * wv[0] + sv[1] * wv[1] + sv[2] * wv[2] + sv[3] * wv[3]; }
        }
#pragma unroll
        for (int i = 0; i < 9; ++i) red[(kg * 9 + i) * 64 + col] = acc[i];
        __syncthreads();
        float* mod = (float*)(P.ws + WS_MOD);
        for (int o = tid; o < 9 * 64; o += NTHREADS) { const int i = o >> 6, cc = o & 63; float a = P.b_ada[L * 3072 + jb * 64 + cc];
#pragma unroll
            for (int q = 0; q < 8; ++q) a += red[(q * 9 + i) * 64 + cc];
            mod[((size_t)L * 9 + i) * 3072 + jb * 64 + cc] = a; }
        __syncthreads();
    }
    if (bid == G - 1 && tid < 16) {
        float* rt = (float*)(P.ws + WS_ROPE);
        double inv = 1.0; for (int j = 0; j < tid; ++j) inv *= 0.5623413251903491;
        const double x = inv, x2 = x * x;
        double sn = x, term = x; for (int n = 1; n < 12; ++n) { term *= -x2 / ((2.0 * n) * (2.0 * n + 1.0)); sn += term; }
        double cs = 1.0; term = 1.0; for (int n = 1; n < 12; ++n) { term *= -x2 / ((2.0 * n - 1.0) * (2.0 * n)); cs += term; }
        double c = 1.0, sv = 0.0;
        for (int pos = 0; pos < 64; ++pos) {
            rt[512 + pos * 16 + tid] = (float)c; rt[1536 + pos * 16 + tid] = (float)sv;
            if (pos < 16) { rt[pos * 16 + tid] = (float)c; rt[256 + pos * 16 + tid] = (float)sv; }
            const double c2 = c * cs - sv * sn, s2 = sv * cs + c * sn; c = c2; sv = s2;
        }
    }
    tr_range(P, lds, 0, 1088, bid, G);
}

__device__ void modulate_phase(const Params& P, int L) {
    const int tid_ = otid(); const int lane = tid_ & 63, gw = ((gridDim.x & 7) == 0 ? ((int)blockIdx.x & 7) * ((int)gridDim.x >> 3) + ((int)blockIdx.x >> 3) : (int)blockIdx.x) * 8 + (tid_ >> 6), nw = gridDim.x * 8;
    const float* mod = (const float*)(P.ws + WS_MOD) + (size_t)L * 9 * 3072;
    bf16_t* h = (bf16_t*)(P.ws + WS_HMIX);
    const float* g = P.norm_g + L * 1024;
    for (int row = gw; row < NTOK; row += nw) {
        const float* xr = (L == 0) ? (row < NPR ? P.x_prompt + (size_t)row * DM : P.x_sample + (size_t)(row - NPR) * DM) : P.out + (size_t)row * DM;
        const int mi = row < NPR ? 0 : 1 + ((row - NPR) >> 10);
        const float* mr = mod + mi * 3072;
        f32x4 v[4], gv[4], sh[4], sc[4]; float ss = 0.f;
#pragma unroll
        for (int i = 0; i < 4; ++i) { const int c = i * 256 + lane * 4; v[i] = *(const f32x4*)(xr + c); gv[i] = *(const f32x4*)(g + c); sh[i] = *(const f32x4*)(mr + c); sc[i] = *(const f32x4*)(mr + 1024 + c); }
#pragma unroll
        for (int i = 0; i < 4; ++i) ss += v[i][0] * v[i][0] + v[i][1] * v[i][1] + v[i][2] * v[i][2] + v[i][3] * v[i][3];
        ss = allred64(ss);
        const float rs = rsqrtf(ss * (1.0f / 1024.0f) + 1e-6f);
#pragma unroll
        for (int i = 0; i < 4; ++i) { const int c = i * 256 + lane * 4;
            float o[4];
#pragma unroll
            for (int j = 0; j < 4; ++j) o[j] = v[i][j] * rs * gv[i][j] * (1.0f + sc[i][j]) + sh[i][j];
            u32x2 w; w.x = cvt_pk_bf16(o[0], o[1]); w.y = cvt_pk_bf16(o[2], o[3]); *(u32x2*)(h + (size_t)row * DM + c) = w; }
    }
}
__device__ void final_phase(const Params& P) {
    const int tid_ = otid(); const int lane = tid_ & 63, gw = ((gridDim.x & 7) == 0 ? ((int)blockIdx.x & 7) * ((int)gridDim.x >> 3) + ((int)blockIdx.x >> 3) : (int)blockIdx.x) * 8 + (tid_ >> 6), nw = gridDim.x * 8;
    f32x4 gv[4];
#pragma unroll
    for (int i = 0; i < 4; ++i) gv[i] = *(const f32x4*)(P.final_g + i * 256 + lane * 4);
    for (int row = gw; row < NTOK; row += nw) {
        float* xr = P.out + (size_t)row * DM;
        f32x4 v[4]; float ss = 0.f;
#pragma unroll
        for (int i = 0; i < 4; ++i) { v[i] = *(const f32x4*)(xr + i * 256 + lane * 4); ss += v[i][0] * v[i][0] + v[i][1] * v[i][1] + v[i][2] * v[i][2] + v[i][3] * v[i][3]; }
        ss = allred64(ss);
        const float rs = rsqrtf(ss * (1.0f / 1024.0f) + 1e-6f);
#pragma unroll
        for (int i = 0; i < 4; ++i) *(f32x4*)(xr + i * 256 + lane * 4) = v[i] * rs * gv[i];
    }
}

constexpr int TP = 68;
constexpr int TA = 16 * TP * 4;
constexpr int SC_R = 0, SC_V = TA, SC_W = 2 * TA, SC_K = 3 * TA, SC_KK = 4 * TA, SC_B = 5 * TA, SC_FK = 6 * TA, SC_TL = 7 * TA, SC_LA = SC_TL + 2304, SC_KDT = SC_LA + 2304, SC_BT = SC_KDT + 2560, SC_GC = SC_BT + 2560, SC_KTB = SC_GC + 256, SC_RTB = SC_KTB + 2304, SC_PB = SC_RTB + 2304;
constexpr int SC_Y = 2 * SC_PB, SC_BSP = SC_Y + 4096, SC_AKT = SC_BSP + 256, SC_TINV = SC_AKT + 1280, SC_GKR = SC_TINV + 1280, SC_GBR = SC_GKR + 1280, SC_ABTT = SC_GBR + 1280, SC_NO = SC_ABTT + 1280, SC_END = SC_NO + 1280;
static_assert(SC_END <= 131072, "scan LDS");

__device__ __forceinline__ f32x4 shift4(u32x2 pv, u32x2 cv, u32x2 nv, bool hp, bool hn, f32x4 mu) {
    f32x4 f = {bflo(cv.x), bfhi(cv.x), bflo(cv.y), bfhi(cv.y)};
    f32x4 a = {0.f, 0.f, 0.f, 0.f};
    if (hp) a += (f32x4){bflo(pv.x), bfhi(pv.x), bflo(pv.y), bfhi(pv.y)};
    if (hn) a += (f32x4){bflo(nv.x), bfhi(nv.x), bflo(nv.y), bfhi(nv.y)};
    return f + mu * (0.5f * a - f);
}
#define MF32(a, b, c) __builtin_amdgcn_mfma_f32_16x16x4f32((a), (b), (c), 0, 0, 0)

#define LBAR() do { asm volatile("s_waitcnt lgkmcnt(0)" ::: "memory"); __builtin_amdgcn_s_barrier(); asm volatile("" ::: "memory"); } while (0)
template <bool SMP> __device__ void scan_chain(const Params& P, LAS unsigned char* lds, int p, int b, int h, int d) {
    const int tid = otid(), wave = __builtin_amdgcn_readfirstlane(tid >> 6), lane = tid & 63, l15 = lane & 15, q4 = lane >> 4;
    const bool isA = wave >= 4; const int ptid = tid & 255, pw = wave & 3;
    const int Lseq = SMP ? 1024 : 256; const int rowbase = SMP ? NPR + b * 1024 : b * 256;
    const int nchunks = Lseq >> 4;
    const bf16_t* proj = (const bf16_t*)(P.ws + WS_PROJ);
    float* bsg = (float*)(P.ws + WS_BS);
    bf16_t* yg = (bf16_t*)(P.ws + WS_Y);
    const int tt1 = ptid >> 4, q1 = ptid & 15;
    const int tr1 = d ? 15 - tt1 : tt1;
    if (isA) {
        bf16x8 bw[2], ba[2];
        { const int c = h * 64 + pw * 16 + l15; const float* w2 = P.lora_w2 + ((size_t)(p * 2 + d) * 64) * 512 + c; const float* a2 = P.lora_a2 + ((size_t)(p * 2 + d) * 64) * 512 + c;
#pragma unroll
          for (int ks = 0; ks < 2; ++ks) { float fw[8], fa[8];
#pragma unroll
              for (int e = 0; e < 8; ++e) { const int r = ks * 32 + q4 * 8 + e; fw[e] = w2[(size_t)r * 512]; fa[e] = a2[(size_t)r * 512]; }
              u32x4 uw, ua; uw.x = cvt_pk_bf16(fw[0], fw[1]); uw.y = cvt_pk_bf16(fw[2], fw[3]); uw.z = cvt_pk_bf16(fw[4], fw[5]); uw.w = cvt_pk_bf16(fw[6], fw[7]);
              ua.x = cvt_pk_bf16(fa[0], fa[1]); ua.y = cvt_pk_bf16(fa[2], fa[3]); ua.z = cvt_pk_bf16(fa[4], fa[5]); ua.w = cvt_pk_bf16(fa[6], fa[7]);
              bw[ks] = __builtin_bit_cast(bf16x8, uw); ba[ks] = __builtin_bit_cast(bf16x8, ua); } }
        const int c2 = pw * 16 + l15, hc2 = h * 64 + c2;
        const float w0c = P.w0[(p * 2 + d) * 512 + hc2], a0c = P.a0[(p * 2 + d) * 512 + hc2], kac = P.k_a[p * 512 + hc2], rkc = P.r_k[p * 512 + hc2];
        const int co_r = h * 64 + q1 * 4, co_k = 512 + co_r, co_v = 1024 + co_r, co_lw = 1536 + d * 64 + q1 * 4, co_la = 1664 + d * 64 + q1 * 4;
        const f32x4 mu_r = *(const f32x4*)(P.mu_shift + p * 1792 + co_r), mu_k = *(const f32x4*)(P.mu_shift + p * 1792 + co_k), mu_v = *(const f32x4*)(P.mu_shift + p * 1792 + co_v),
                    mu_lw = *(const f32x4*)(P.mu_shift + p * 1792 + co_lw), mu_la = *(const f32x4*)(P.mu_shift + p * 1792 + co_la), kk4 = *(const f32x4*)(P.k_k + p * 512 + h * 64 + q1 * 4);
        u32x2 g_r[2][3], g_k[2][3], g_v[2][3], g_lw[2][3], g_la[2][3];
#define SC_PRELOAD(ci_, S_) do { const int t0_ = d ? Lseq - 16 * ((ci_) + 1) : 16 * (ci_); const int t_ = t0_ + tt1; \
        const bf16_t* rc_ = proj + (size_t)(rowbase + t_) * EVEN_IN; const bf16_t* rp_ = rc_ - EVEN_IN; const bf16_t* rn_ = rc_ + EVEN_IN;     \
        g_r[S_][0] = *(const u32x2*)(rp_ + co_r); g_r[S_][1] = *(const u32x2*)(rc_ + co_r); g_r[S_][2] = *(const u32x2*)(rn_ + co_r); \
        g_k[S_][0] = *(const u32x2*)(rp_ + co_k); g_k[S_][1] = *(const u32x2*)(rc_ + co_k); g_k[S_][2] = *(const u32x2*)(rn_ + co_k); \
        g_v[S_][0] = *(const u32x2*)(rp_ + co_v); g_v[S_][1] = *(const u32x2*)(rc_ + co_v); g_v[S_][2] = *(const u32x2*)(rn_ + co_v); \
        g_lw[S_][0] = *(const u32x2*)(rp_ + co_lw); g_lw[S_][1] = *(const u32x2*)(rc_ + co_lw); g_lw[S_][2] = *(const u32x2*)(rn_ + co_lw); \
        g_la[S_][0] = *(const u32x2*)(rp_ + co_la); g_la[S_][1] = *(const u32x2*)(rc_ + co_la); g_la[S_][2] = *(const u32x2*)(rn_ + co_la); } while (0)
        SC_PRELOAD(0, 0); SC_PRELOAD(1, 1);
        for (int cc2 = 0; cc2 < nchunks; cc2 += 2) {
#pragma unroll
          for (int par = 0; par < 2; ++par) {
            const int cc = cc2 + par;
            constexpr bool act = true;
            LAS unsigned char* cl = lds + (cc & 1) * SC_PB;
            const int t0 = d ? Lseq - 16 * (cc + 1) : 16 * cc;
            if (act) {
                const int t = t0 + tt1; const bool hp = t > 0, hn = t < Lseq - 1;
                const f32x4 fr = shift4(g_r[par][0], g_r[par][1], g_r[par][2], hp, hn, mu_r);
                const f32x4 fk = shift4(g_k[par][0], g_k[par][1], g_k[par][2], hp, hn, mu_k);
                const f32x4 fv = shift4(g_v[par][0], g_v[par][1], g_v[par][2], hp, hn, mu_v);
                const f32x4 flw = shift4(g_lw[par][0], g_lw[par][1], g_lw[par][2], hp, hn, mu_lw);
                const f32x4 fla = shift4(g_la[par][0], g_la[par][1], g_la[par][2], hp, hn, mu_la);
                *(LAS f32x4*)(cl + SC_R + (tr1 * TP + q1 * 4) * 4) = fr;
                *(LAS f32x4*)(cl + SC_V + (tr1 * TP + q1 * 4) * 4) = fv;
                *(LAS f32x4*)(cl + SC_FK + (tr1 * TP + q1 * 4) * 4) = fk;
                f32x4 kr = fk * kk4; float ss = kr[0] * kr[0] + kr[1] * kr[1] + kr[2] * kr[2] + kr[3] * kr[3];
                ss = allred16(ss);
                const float inv = __builtin_amdgcn_rsqf(fmaxf(ss, 1e-24f));
                *(LAS f32x4*)(cl + SC_KK + (tr1 * TP + q1 * 4) * 4) = kr * inv;
                u32x2 tw; tw.x = cvt_pk_bf16(tanhf_(flw[0]), tanhf_(flw[1])); tw.y = cvt_pk_bf16(tanhf_(flw[2]), tanhf_(flw[3]));
                *(LAS u32x2*)(cl + SC_TL + (tr1 * 72 + q1 * 4) * 2) = tw;
                u32x2 aw; aw.x = cvt_pk_bf16(fla[0], fla[1]); aw.y = cvt_pk_bf16(fla[2], fla[3]);
                *(LAS u32x2*)(cl + SC_LA + (tr1 * 72 + q1 * 4) * 2) = aw;
                { const int cn = cc + 2 < nchunks ? cc + 2 : nchunks - 1; SC_PRELOAD(cn, par); }
            }
            LBAR();
            if (act) {
                f32x4 wl = {0.f, 0.f, 0.f, 0.f}, al = {0.f, 0.f, 0.f, 0.f};
#pragma unroll
                for (int ks = 0; ks < 2; ++ks) {
                    const bf16x8 atl = *(const LAS bf16x8*)(cl + SC_TL + (l15 * 72 + ks * 32 + q4 * 8) * 2);
                    const bf16x8 ala = *(const LAS bf16x8*)(cl + SC_LA + (l15 * 72 + ks * 32 + q4 * 8) * 2);
                    wl = __builtin_amdgcn_mfma_f32_16x16x32_bf16(atl, bw[ks], wl, 0, 0, 0);
                    al = __builtin_amdgcn_mfma_f32_16x16x32_bf16(ala, ba[ks], al, 0, 0, 0);
                }
                float bsp[4];
#pragma unroll
                for (int j = 0; j < 4; ++j) {
                    const int t = q4 * 4 + j;
                    const float w = __expf(-0.6065306597f * sigmoidf_(w0c + wl[j]));
                    const float a = sigmoidf_(a0c + al[j]);
                    const float k = *(const LAS float*)(cl + SC_FK + (t * TP + c2) * 4);
                    const float kd = k * (1.0f + (a - 1.0f) * kac);
                    const float kkv = *(const LAS float*)(cl + SC_KK + (t * TP + c2) * 4);
                    *(LAS float*)(cl + SC_W + (t * TP + c2) * 4) = w;
                    *(LAS float*)(cl + SC_K + (t * TP + c2) * 4) = kd;
                    *(LAS float*)(cl + SC_B + (t * TP + c2) * 4) = kkv * a;
                    const float r = *(const LAS float*)(cl + SC_R + (t * TP + c2) * 4);
                    bsp[j] = allred16(r * kd * rkc);
                }
                if (l15 == 0) {
#pragma unroll
                    for (int j = 0; j < 4; ++j) *(LAS float*)(lds + SC_BSP + (pw * 16 + q4 * 4 + j) * 4) = bsp[j];
                }
            }
            LBAR();
            if (act) {
                const int c = lane;
                float g[16];
#pragma unroll
                for (int t = 0; t < 16; ++t) g[t] = *(const LAS float*)(cl + SC_W + (t * TP + c) * 4);
#pragma unroll
                for (int t = 1; t < 16; ++t) g[t] *= g[t - 1];
                if (pw == 0) {
                    float kk[16];
#pragma unroll
                    for (int t = 0; t < 16; ++t) kk[t] = *(const LAS float*)(cl + SC_KK + (t * TP + c) * 4);
#pragma unroll
                    for (int t = 1; t < 16; ++t) { kk[t] *= g[t - 1]; *(LAS float*)(cl + SC_KK + (t * TP + c) * 4) = kk[t]; }
#pragma unroll
                    for (int t = 0; t < 16; t += 2) { const unsigned w = cvt_pk_bf16(kk[t], kk[t + 1]); *(LAS bf16_t*)(cl + SC_KTB + (t * 72 + c) * 2) = (bf16_t)(w & 0xffff); *(LAS bf16_t*)(cl + SC_KTB + ((t + 1) * 72 + c) * 2) = (bf16_t)(w >> 16); }
                    *(LAS float*)(cl + SC_GC + c * 4) = g[15];
                } else if (pw == 1) {
                    float rr[16];
#pragma unroll
                    for (int t = 0; t < 16; ++t) rr[t] = *(const LAS float*)(cl + SC_R + (t * TP + c) * 4);
#pragma unroll
                    for (int t = 0; t < 16; ++t) { rr[t] *= g[t]; *(LAS float*)(cl + SC_R + (t * TP + c) * 4) = rr[t]; }
#pragma unroll
                    for (int t = 0; t < 16; t += 2) { const unsigned w = cvt_pk_bf16(rr[t], rr[t + 1]); *(LAS bf16_t*)(cl + SC_RTB + (t * 72 + c) * 2) = (bf16_t)(w & 0xffff); *(LAS bf16_t*)(cl + SC_RTB + ((t + 1) * 72 + c) * 2) = (bf16_t)(w >> 16); }
                } else if (pw == 2) {
                    float kd[16];
#pragma unroll
                    for (int t = 0; t < 16; ++t) kd[t] = *(const LAS float*)(cl + SC_K + (t * TP + c) * 4);
#pragma unroll
                    for (int t = 0; t < 16; ++t) { kd[t] *= __builtin_amdgcn_rcpf(g[t]); *(LAS float*)(cl + SC_K + (t * TP + c) * 4) = kd[t]; }
#pragma unroll
                    for (int t8 = 0; t8 < 2; ++t8) { u32x4 w; w.x = cvt_pk_bf16(kd[8 * t8], kd[8 * t8 + 1]); w.y = cvt_pk_bf16(kd[8 * t8 + 2], kd[8 * t8 + 3]); w.z = cvt_pk_bf16(kd[8 * t8 + 4], kd[8 * t8 + 5]); w.w = cvt_pk_bf16(kd[8 * t8 + 6], kd[8 * t8 + 7]);
                        *(LAS u32x2*)(cl + SC_KDT + c * 40 + t8 * 16) = (u32x2){w.x, w.y}; *(LAS u32x2*)(cl + SC_KDT + c * 40 + t8 * 16 + 8) = (u32x2){w.z, w.w}; }
                } else {
                    float bt[16];
#pragma unroll
                    for (int t = 0; t < 16; ++t) bt[t] = *(const LAS float*)(cl + SC_B + (t * TP + c) * 4);
#pragma unroll
                    for (int t = 0; t < 16; ++t) { bt[t] *= __builtin_amdgcn_rcpf(g[t]); *(LAS float*)(cl + SC_B + (t * TP + c) * 4) = bt[t]; }
#pragma unroll
                    for (int t8 = 0; t8 < 2; ++t8) { u32x4 w; w.x = cvt_pk_bf16(-bt[8 * t8], -bt[8 * t8 + 1]); w.y = cvt_pk_bf16(-bt[8 * t8 + 2], -bt[8 * t8 + 3]); w.z = cvt_pk_bf16(-bt[8 * t8 + 4], -bt[8 * t8 + 5]); w.w = cvt_pk_bf16(-bt[8 * t8 + 6], -bt[8 * t8 + 7]);
                        *(LAS u32x2*)(cl + SC_BT + c * 40 + t8 * 16) = (u32x2){w.x, w.y}; *(LAS u32x2*)(cl + SC_BT + c * 40 + t8 * 16 + 8) = (u32x2){w.z, w.w}; }
                }
            }
            LBAR();
          }
        }
        LBAR(); LBAR(); LBAR();
#undef SC_PRELOAD
    } else {
        const int vt = pw;
        f32x4 St[4];
#pragma unroll
        for (int kt = 0; kt < 4; ++kt) St[kt] = (f32x4){0.f, 0.f, 0.f, 0.f};
        if (SMP) {
            const float* s0 = P.state_rwkv + ((((size_t)b * 2 + p) * 2 + d) * 8 + h) * 4096 + (16 * vt + l15) * 64 + 4 * q4;
#pragma unroll
            for (int kt = 0; kt < 4; ++kt) St[kt] = *(const f32x4*)(s0 + 16 * kt);
        }
        for (int cc = 0; cc <= nchunks; ++cc) {
            const bool act = cc > 0; const int ci = cc - 1;
            const LAS unsigned char* cl = lds + (ci & 1) * SC_PB;
            const int t0 = d ? Lseq - 16 * (ci + 1) : 16 * ci;
            if (act) {
                const LAS unsigned char* xa = cl + (pw < 2 ? SC_KK : SC_R) + (l15 * TP + 4 * q4) * 4;
                const LAS unsigned char* zb = cl + ((pw & 1) ? SC_B : SC_K) + (l15 * TP + 4 * q4) * 4;
                f32x4 ga4[4], gb4_[4];
#pragma unroll
                for (int kt = 0; kt < 4; ++kt) { ga4[kt] = *(const LAS f32x4*)(xa + kt * 64); gb4_[kt] = *(const LAS f32x4*)(zb + kt * 64); }
                f32x4 acc = {0.f, 0.f, 0.f, 0.f};
                if (pw == 1) {
                    f32x4 ac[4];
#pragma unroll
                    for (int kt = 0; kt < 4; ++kt) ac[kt] = (f32x4){0.f, 0.f, 0.f, 0.f};
#pragma unroll
                    for (int j = 0; j < 4; ++j)
#pragma unroll
                        for (int kt = 0; kt < 4; ++kt) ac[kt] = MF32(ga4[kt][j], gb4_[kt][j], ac[kt]);
                    acc = (ac[0] + ac[1]) + (ac[2] + ac[3]);
                } else {
#pragma unroll
                    for (int ks = 0; ks < 2; ++ks) { const u32x4 ua = {cvt_pk_bf16(ga4[2 * ks][0], ga4[2 * ks][1]), cvt_pk_bf16(ga4[2 * ks][2], ga4[2 * ks][3]), cvt_pk_bf16(ga4[2 * ks + 1][0], ga4[2 * ks + 1][1]), cvt_pk_bf16(ga4[2 * ks + 1][2], ga4[2 * ks + 1][3])};
                        const u32x4 ub = {cvt_pk_bf16(gb4_[2 * ks][0], gb4_[2 * ks][1]), cvt_pk_bf16(gb4_[2 * ks][2], gb4_[2 * ks][3]), cvt_pk_bf16(gb4_[2 * ks + 1][0], gb4_[2 * ks + 1][1]), cvt_pk_bf16(gb4_[2 * ks + 1][2], gb4_[2 * ks + 1][3])};
                        acc = __builtin_amdgcn_mfma_f32_16x16x32_bf16(__builtin_bit_cast(bf16x8, ua), __builtin_bit_cast(bf16x8, ub), acc, 0, 0, 0); }
                }
                if (pw != 1) {
                    LAS unsigned char* mo = lds + (pw == 0 ? SC_AKT : pw == 2 ? SC_GKR : SC_GBR);
#pragma unroll
                    for (int j = 0; j < 4; ++j) { const int t = 4 * q4 + j; const bool keep = (pw == 0) ? (l15 < t) : (l15 <= t); float v = keep ? acc[j] : 0.f; if (pw == 3) v = -v;
                        *(LAS float*)(mo + (t * 20 + l15) * 4) = v; }
                } else {
#pragma unroll
                    for (int j = 0; j < 4; ++j) { const int t = 4 * q4 + j; const float v = (l15 < t) ? acc[j] : 0.f; const bool same = (l15 >> 2) == q4;
                        *(LAS float*)(lds + SC_ABTT + (t * 20 + l15) * 4) = same ? v : 0.f; *(LAS float*)(lds + SC_NO + (t * 20 + l15) * 4) = same ? 0.f : v; }
                    asm volatile("s_waitcnt lgkmcnt(0)" ::: "memory");
                    float r0_ = (4 * q4 + 0 == l15) ? 1.f : 0.f, r1_ = (4 * q4 + 1 == l15) ? 1.f : 0.f, r2_ = (4 * q4 + 2 == l15) ? 1.f : 0.f, r3_ = (4 * q4 + 3 == l15) ? 1.f : 0.f, u0_, u1_, u2_, u3_;
                    const f32x4 dg1 = *(const LAS f32x4*)(lds + SC_ABTT + ((4 * q4 + 1) * 20 + 4 * q4) * 4), dg2 = *(const LAS f32x4*)(lds + SC_ABTT + ((4 * q4 + 2) * 20 + 4 * q4) * 4),
                                dg3 = *(const LAS f32x4*)(lds + SC_ABTT + ((4 * q4 + 3) * 20 + 4 * q4) * 4);
                    f32x4 cN[3][4];
#pragma unroll
                    for (int bb = 0; bb < 3; ++bb)
#pragma unroll
                        for (int j = 0; j < 4; ++j) cN[bb][j] = *(const LAS f32x4*)(lds + SC_NO + ((4 * q4 + j) * 20 + 4 * bb) * 4);
#define DIAGSOLVE() do { u0_ = r0_; u1_ = r1_ - dg1[0] * u0_; u2_ = r2_ - dg2[0] * u0_ - dg2[1] * u1_; u3_ = r3_ - dg3[0] * u0_ - dg3[1] * u1_ - dg3[2] * u2_; } while (0)
#pragma unroll
                    for (int bb = 0; bb < 3; ++bb) {
                        DIAGSOLVE();
                        const int src = l15 + 16 * bb;
                        const float b0 = __shfl(u0_, src), b1 = __shfl(u1_, src), b2 = __shfl(u2_, src), b3 = __shfl(u3_, src);
                        r0_ -= cN[bb][0][0] * b0 + cN[bb][0][1] * b1 + cN[bb][0][2] * b2 + cN[bb][0][3] * b3;
                        r1_ -= cN[bb][1][0] * b0 + cN[bb][1][1] * b1 + cN[bb][1][2] * b2 + cN[bb][1][3] * b3;
                        r2_ -= cN[bb][2][0] * b0 + cN[bb][2][1] * b1 + cN[bb][2][2] * b2 + cN[bb][2][3] * b3;
                        r3_ -= cN[bb][3][0] * b0 + cN[bb][3][1] * b1 + cN[bb][3][2] * b2 + cN[bb][3][3] * b3;
                    }
                    DIAGSOLVE();
#undef DIAGSOLVE
                    *(LAS float*)(lds + SC_TINV + ((4 * q4 + 0) * 20 + l15) * 4) = u0_; *(LAS float*)(lds + SC_TINV + ((4 * q4 + 1) * 20 + l15) * 4) = u1_;
                    *(LAS float*)(lds + SC_TINV + ((4 * q4 + 2) * 20 + l15) * 4) = u2_; *(LAS float*)(lds + SC_TINV + ((4 * q4 + 3) * 20 + l15) * 4) = u3_;
                }
            }
            LBAR();
            if (act) {
#define PK4(v) cvt_pk_bf16((v)[0], (v)[1]), cvt_pk_bf16((v)[2], (v)[3])
                f32x4 vB;
#pragma unroll
                for (int j = 0; j < 4; ++j) vB[j] = *(const LAS float*)(cl + SC_V + ((4 * q4 + j) * TP + 16 * vt + l15) * 4);
                bf16x8 bS[2];
#pragma unroll
                for (int ks = 0; ks < 2; ++ks) { const u32x4 w = {PK4(St[2 * ks]), PK4(St[2 * ks + 1])}; bS[ks] = __builtin_bit_cast(bf16x8, w); }
                f32x4 rhs = {0.f, 0.f, 0.f, 0.f}, yv = {0.f, 0.f, 0.f, 0.f};
#pragma unroll
                for (int ks = 0; ks < 2; ++ks) {
                    const u32x2 k0 = *(const LAS u32x2*)(cl + SC_KTB + (l15 * 72 + 32 * ks + 4 * q4) * 2), k1 = *(const LAS u32x2*)(cl + SC_KTB + (l15 * 72 + 32 * ks + 16 + 4 * q4) * 2);
                    const u32x2 r0 = *(const LAS u32x2*)(cl + SC_RTB + (l15 * 72 + 32 * ks + 4 * q4) * 2), r1 = *(const LAS u32x2*)(cl + SC_RTB + (l15 * 72 + 32 * ks + 16 + 4 * q4) * 2);
                    const u32x4 ak = {k0.x, k0.y, k1.x, k1.y}, ar = {r0.x, r0.y, r1.x, r1.y};
                    rhs = __builtin_amdgcn_mfma_f32_16x16x32_bf16(__builtin_bit_cast(bf16x8, ak), bS[ks], rhs, 0, 0, 0);
                    yv = __builtin_amdgcn_mfma_f32_16x16x32_bf16(__builtin_bit_cast(bf16x8, ar), bS[ks], yv, 0, 0, 0);
                }
                const f32x4 a4 = *(const LAS f32x4*)(lds + SC_AKT + (l15 * 20 + 4 * q4) * 4), gk4 = *(const LAS f32x4*)(lds + SC_GKR + (l15 * 20 + 4 * q4) * 4), gb4 = *(const LAS f32x4*)(lds + SC_GBR + (l15 * 20 + 4 * q4) * 4);
                { const u32x4 aa = {PK4(a4), 0u, 0u}, bv = {PK4(vB), 0u, 0u};
                  rhs = __builtin_amdgcn_mfma_f32_16x16x32_bf16(__builtin_bit_cast(bf16x8, aa), __builtin_bit_cast(bf16x8, bv), rhs, 0, 0, 0); }
                f32x4 u = {0.f, 0.f, 0.f, 0.f};
                { const f32x4 t4 = *(const LAS f32x4*)(lds + SC_TINV + (l15 * 20 + 4 * q4) * 4);
#pragma unroll
                  for (int j = 0; j < 4; ++j) u = MF32(t4[j], rhs[j], u); }
                const u32x4 bvu_ = {PK4(vB), PK4(u)}; const bf16x8 bVU = __builtin_bit_cast(bf16x8, bvu_);
                { const u32x4 ag = {PK4(gk4), PK4(gb4)};
                  yv = __builtin_amdgcn_mfma_f32_16x16x32_bf16(__builtin_bit_cast(bf16x8, ag), bVU, yv, 0, 0, 0); }
#pragma unroll
                for (int j = 0; j < 4; ++j) *(LAS float*)(lds + SC_Y + ((4 * q4 + j) * 64 + 16 * vt + l15) * 4) = yv[j];
#pragma unroll
                for (int kt = 0; kt < 4; ++kt) { const u32x2 kd4 = *(const LAS u32x2*)(cl + SC_KDT + (16 * kt + l15) * 40 + 8 * q4), bt4 = *(const LAS u32x2*)(cl + SC_BT + (16 * kt + l15) * 40 + 8 * q4);
                    const u32x4 as_ = {kd4.x, kd4.y, bt4.x, bt4.y};
                    St[kt] = __builtin_amdgcn_mfma_f32_16x16x32_bf16(__builtin_bit_cast(bf16x8, as_), bVU, St[kt], 0, 0, 0);
                    const f32x4 gc = *(const LAS f32x4*)(cl + SC_GC + (16 * kt + 4 * q4) * 4);
                    St[kt] = St[kt] * gc; }
#undef PK4
            }
            LBAR();
            if (cc < nchunks && tid < 16) {
                const int t0c = d ? Lseq - 16 * (cc + 1) : 16 * cc;
                float a = 0.f;
#pragma unroll
                for (int q = 0; q < 4; ++q) a += *(const LAS float*)(lds + SC_BSP + (q * 16 + tid) * 4);
                bsg[((size_t)d * NTOK + rowbase + t0c + (d ? 15 - tid : tid)) * 8 + h] = 0.5f * a;
            }
            if (act) {
                const f32x4 yv = *(const LAS f32x4*)(lds + SC_Y + (tr1 * 64 + q1 * 4) * 4);
                u32x2 w; w.x = cvt_pk_bf16(yv[0], yv[1]); w.y = cvt_pk_bf16(yv[2], yv[3]);
                *(u32x2*)(yg + ((size_t)d * NTOK + rowbase + t0 + tt1) * 512 + h * 64 + q1 * 4) = w;
            }
            LBAR();
        }
        if (!SMP) {
            float* so = P.out + OUT_STATE + ((((size_t)b * 2 + p) * 2 + d) * 8 + h) * 4096 + (16 * vt + l15) * 64 + 4 * q4;
#pragma unroll
            for (int kt = 0; kt < 4; ++kt) *(f32x4*)(so + 16 * kt) = St[kt];
        }
    }
    __syncthreads();
}

__device__ void scan_phase(const Params& P, LAS unsigned char* lds, int p) {
    const int bid = blockIdx.x;
    if (bid < 128) { scan_chain<true>(P, lds, p, bid >> 4, (bid >> 1) & 7, bid & 1); }
    else { for (int j = 0; j < 4; ++j) { const int idx = (bid - 128) + 128 * j; scan_chain<false>(P, lds, p, idx >> 4, (idx >> 1) & 7, idx & 1); } }
}

__device__ __forceinline__ void unpack8(u32x4 v, float (&f)[8]) { f[0] = bflo(v.x); f[1] = bfhi(v.x); f[2] = bflo(v.y); f[3] = bfhi(v.y); f[4] = bflo(v.z); f[5] = bfhi(v.z); f[6] = bflo(v.w); f[7] = bfhi(v.w); }
__device__ __forceinline__ u32x4 pack8(const float (&f)[8]) { u32x4 w; w.x = cvt_pk_bf16(f[0], f[1]); w.y = cvt_pk_bf16(f[2], f[3]); w.z = cvt_pk_bf16(f[4], f[5]); w.w = cvt_pk_bf16(f[6], f[7]); return w; }
__device__ void even_post_phase(const Params& P, int p) {
    const int tid_ = otid(); const int lane = tid_ & 63, gw = ((gridDim.x & 7) == 0 ? ((int)blockIdx.x & 7) * ((int)gridDim.x >> 3) + ((int)blockIdx.x >> 3) : (int)blockIdx.x) * 8 + (tid_ >> 6), nw = gridDim.x * 8;
    const bf16_t* proj = (const bf16_t*)(P.ws + WS_PROJ); const bf16_t* yg = (const bf16_t*)(P.ws + WS_Y); const float* bsg = (const float*)(P.ws + WS_BS);
    bf16_t* mix = (bf16_t*)(P.ws + WS_HMIX);
    const int c = lane * 8, h = lane >> 3;
    float lg[8], lb[8], muv[8], cw0[8], cw1[8], cw2[8], cb[8];
#pragma unroll
    for (int j = 0; j < 8; ++j) { lg[j] = P.lnx_g[p * 512 + c + j]; lb[j] = P.lnx_b[p * 512 + c + j]; muv[j] = P.mu_shift[p * 1792 + 1024 + c + j];
        cw0[j] = P.conv_w[(p * 3 + 0) * 512 + c + j]; cw1[j] = P.conv_w[(p * 3 + 1) * 512 + c + j]; cw2[j] = P.conv_w[(p * 3 + 2) * 512 + c + j]; cb[j] = P.conv_b[p * 512 + c + j]; }
    for (int row = gw; row < NTOK; row += nw) {
        const bool smp = row >= NPR; const int t = smp ? (row - NPR) & 1023 : row & 255; const int Lseq = smp ? 1024 : 256;
        const bool hp = t > 0, hn = t < Lseq - 1;
        const bf16_t* rc = proj + (size_t)row * EVEN_IN; const bf16_t* rp = hp ? rc - EVEN_IN : rc; const bf16_t* rn = hn ? rc + EVEN_IN : rc;
        const u32x4 r_yf = *(const u32x4*)(yg + (size_t)row * 512 + c), r_yb = *(const u32x4*)(yg + ((size_t)NTOK + row) * 512 + c);
        const u32x4 r_vc = *(const u32x4*)(rc + 1024 + c), r_vp = *(const u32x4*)(rp + 1024 + c), r_vn = *(const u32x4*)(rn + 1024 + c), r_ga = *(const u32x4*)(rc + 1792 + c);
        const u32x4 r_cgc = *(const u32x4*)(rc + 2816 + c), r_xc = *(const u32x4*)(rc + 3328 + c), r_cgp = *(const u32x4*)(rp + 2816 + c), r_xp = *(const u32x4*)(rp + 3328 + c);
        const u32x4 r_cgn = *(const u32x4*)(rn + 2816 + c), r_xn = *(const u32x4*)(rn + 3328 + c), r_bg = *(const u32x4*)(rc + 2304 + c), r_gb = *(const u32x4*)(rc + 3840 + c);
        const float bonus = bsg[(size_t)row * 8 + h] + bsg[((size_t)NTOK + row) * 8 + h];
        float yf[8], yb[8], y[8];
        unpack8(r_yf, yf); unpack8(r_yb, yb);
        float s = 0.f;
#pragma unroll
        for (int j = 0; j < 8; ++j) { y[j] = yf[j] + yb[j]; s += y[j]; }
        const float mean = allred8(s) * (1.0f / 64.0f);
        float q = 0.f;
#pragma unroll
        for (int j = 0; j < 8; ++j) { y[j] -= mean; q += y[j] * y[j]; }
        const float rstd = rsqrtf(allred8(q) * (1.0f / 64.0f) + 64e-5f);
        float vc[8], vp[8], vn[8], ga[8], o[8], o2[8];
        unpack8(r_vc, vc); unpack8(r_vp, vp); unpack8(r_vn, vn); unpack8(r_ga, ga);
#pragma unroll
        for (int j = 0; j < 8; ++j) { const float av = (hp ? vp[j] : 0.f) + (hn ? vn[j] : 0.f); const float fv = vc[j] + muv[j] * (0.5f * av - vc[j]);
            o[j] = (y[j] * rstd * lg[j] + lb[j] + bonus * fv) * siluf_(ga[j]); }
        float cgc[8], xc[8], cgp[8], xp_[8], cgn[8], xn[8], bg[8], gb[8];
        unpack8(r_cgc, cgc); unpack8(r_xc, xc); unpack8(r_cgp, cgp); unpack8(r_xp, xp_); unpack8(r_cgn, cgn); unpack8(r_xn, xn); unpack8(r_bg, bg); unpack8(r_gb, gb);
#pragma unroll
        for (int j = 0; j < 8; ++j) { const float up = hp ? cgp[j] * xp_[j] : 0.f, un = hn ? cgn[j] * xn[j] : 0.f, uc = cgc[j] * xc[j];
            const float cv = up * cw0[j] + uc * cw1[j] + un * cw2[j] + cb[j]; o2[j] = bg[j] * cv * siluf_(gb[j]); }
        *(u32x4*)(mix + (size_t)row * DM + c) = pack8(o);
        *(u32x4*)(mix + (size_t)row * DM + 512 + c) = pack8(o2);
    }
}

__device__ void qknorm_phase(const Params& P, int p) {
    const int tid_ = otid(); const int lane = tid_ & 63, gw = ((gridDim.x & 7) == 0 ? ((int)blockIdx.x & 7) * ((int)gridDim.x >> 3) + ((int)blockIdx.x >> 3) : (int)blockIdx.x) * 8 + (tid_ >> 6), nw = gridDim.x * 8;
    bf16_t* proj = (bf16_t*)(P.ws + WS_PROJ); const float* rt = (const float*)(P.ws + WS_ROPE);
    const float QS = 0.125f * 1.4426950408889634f;
    float qg[16], kg[4];
#pragma unroll
    for (int i = 0; i < 16; ++i) qg[i] = P.q_norm_g[p * 64 + (lane & 3) * 16 + i];
#pragma unroll
    for (int i = 0; i < 4; ++i) kg[i] = P.k_norm_g[p * 64 + (lane & 15) * 4 + i];
    for (int row = gw; row < NTOK; row += nw) {
        const bool smp = row >= NPR; const int t = smp ? (row - NPR) & 1023 : row & 255; const int b = smp ? (row - NPR) >> 10 : row >> 8;
        bf16_t* pr = proj + (size_t)row * ODD_IN;
        const u32x4 r_q0 = *(const u32x4*)(pr + lane * 16), r_q1 = *(const u32x4*)(pr + lane * 16 + 8); const u32x2 r_k = *(const u32x2*)(pr + 1024 + lane * 4), r_v = *(const u32x2*)(pr + 1280 + lane * 4);
        { float x[16]; { float a[8], bq[8]; unpack8(r_q0, a); unpack8(r_q1, bq);
#pragma unroll
              for (int i = 0; i < 8; ++i) { x[i] = a[i]; x[8 + i] = bq[i]; } }
          float ss = 0.f;
#pragma unroll
          for (int i = 0; i < 16; ++i) ss += x[i] * x[i];
          ss = allred4(ss); const float rs = rsqrtf(ss * (1.0f / 64.0f) + 1e-6f);
#pragma unroll
          for (int i = 0; i < 16; ++i) x[i] *= rs * qg[i];
          if (smp) { const int pos = (lane & 2) ? (t & 63) : (t >> 6); const float* ct = rt + ((lane & 2) ? 512 : 0) + pos * 16; const float* st = rt + ((lane & 2) ? 1536 : 256) + pos * 16;
              const float sgn = (lane & 1) ? 1.0f : -1.0f;
#pragma unroll
              for (int i = 0; i < 16; ++i) { const float o = __builtin_bit_cast(float, __builtin_amdgcn_update_dpp(0, __builtin_bit_cast(int, x[i]), 0xB1, 0xf, 0xf, true)); x[i] = x[i] * ct[i] + sgn * o * st[i]; } }
          float o0[8], o1[8];
#pragma unroll
          for (int i = 0; i < 8; ++i) { o0[i] = x[i] * QS; o1[i] = x[8 + i] * QS; }
          *(u32x4*)(pr + lane * 16) = pack8(o0); *(u32x4*)(pr + lane * 16 + 8) = pack8(o1); }
        { const u32x2 kv = r_k; float x[4] = {bflo(kv.x), bfhi(kv.x), bflo(kv.y), bfhi(kv.y)};
          float ss = x[0] * x[0] + x[1] * x[1] + x[2] * x[2] + x[3] * x[3]; ss = allred16(ss); const float rs = rsqrtf(ss * (1.0f / 64.0f) + 1e-6f);
#pragma unroll
          for (int i = 0; i < 4; ++i) x[i] *= rs * kg[i];
          const int hk = lane >> 4, d0 = (lane & 15) * 4;
          if (!smp) { *(f32x4*)(P.out + OUT_CK + ((((size_t)b * 2 + p) * 4 + hk) * 256 + t) * 64 + d0) = (f32x4){x[0], x[1], x[2], x[3]};
              const u32x2 vv = r_v;
              *(f32x4*)(P.out + OUT_CV + ((((size_t)b * 2 + p) * 4 + hk) * 256 + t) * 64 + d0) = (f32x4){bflo(vv.x), bfhi(vv.x), bflo(vv.y), bfhi(vv.y)}; }
          else { const int l16 = lane & 15; const int pos = (l16 & 8) ? (t & 63) : (t >> 6); const float* ct = rt + ((l16 & 8) ? 512 : 0) + pos * 16 + (l16 & 3) * 4; const float* st = rt + ((l16 & 8) ? 1536 : 256) + pos * 16 + (l16 & 3) * 4;
              const float sgn = (l16 & 4) ? 1.0f : -1.0f;
#pragma unroll
              for (int i = 0; i < 4; ++i) { const float o = __builtin_bit_cast(float, __builtin_amdgcn_update_dpp(0, __builtin_bit_cast(int, x[i]), 0x124, 0xf, 0xf, true));
                  const float o2 = __builtin_bit_cast(float, __builtin_amdgcn_update_dpp(0, __builtin_bit_cast(int, x[i]), 0x12C, 0xf, 0xf, true));
                  const float partner = (l16 & 4) ? o2 : o; x[i] = x[i] * ct[i] + sgn * partner * st[i]; } }
          u32x2 w; w.x = cvt_pk_bf16(x[0], x[1]); w.y = cvt_pk_bf16(x[2], x[3]); *(u32x2*)(pr + 1024 + lane * 4) = w; }
    }
}

constexpr int AT_KS = 72;
constexpr int AT_KB = 64 * AT_KS * 2;
__device__ void attn_phase(const Params& P, LAS unsigned char* lds, int p) {
    const int tid = otid(), wave = __builtin_amdgcn_readfirstlane(tid >> 6), lane = tid & 63, l15 = lane & 15, q4 = lane >> 4;
    const bf16_t* proj = (const bf16_t*)(P.ws + WS_PROJ); bf16_t* mix = (bf16_t*)(P.ws + WS_HMIX);
    const int skey = tid >> 3, sds = tid & 7;
    for (int it = 0; it < 4; ++it) {
        const bool smp = it < 2; const int vcu = ((int)blockIdx.x & 7) * 32 + ((int)blockIdx.x >> 3); const int idx = vcu + 256 * (it & 1);
        int b, hk, qb; if (smp) { b = idx >> 6; hk = (idx >> 4) & 3; qb = idx & 15; } else { b = idx >> 4; hk = (idx >> 2) & 3; qb = idx & 3; }
        const int rowbase = smp ? NPR + b * 1024 : b * 256; const int ntiles = smp ? 24 : 4, ncache = smp ? 8 : 0;
        const int g = wave >> 1, tok0 = qb * 64 + (wave & 1) * 32, qh = hk * 4 + g;
        bf16x8 qf[2][2];
#pragma unroll
        for (int nt = 0; nt < 2; ++nt)
#pragma unroll
            for (int ks = 0; ks < 2; ++ks) qf[nt][ks] = *(const bf16x8*)(proj + (size_t)(rowbase + tok0 + nt * 16 + l15) * ODD_IN + qh * 64 + ks * 32 + q4 * 8);
        f32x4 O[4][2]; f32x4 lsumv[2] = {{0.f, 0.f, 0.f, 0.f}, {0.f, 0.f, 0.f, 0.f}};
#pragma unroll
        for (int mt = 0; mt < 4; ++mt)
#pragma unroll
            for (int nt = 0; nt < 2; ++nt) O[mt][nt] = (f32x4){0.f, 0.f, 0.f, 0.f};
        const float* ck = P.cache_k + (((size_t)b * 2 + p) * 4 + hk) * 512 * 64; const float* cv = P.cache_v + (((size_t)b * 2 + p) * 4 + hk) * 512 * 64;
        u32x4 ra0, ra1, ra2, ra3, rb0, rb1, rb2, rb3;
        ra1 = ra3 = rb1 = rb3 = (u32x4){0u, 0u, 0u, 0u};
        auto gload = [&](int j, u32x4& r0, u32x4& r1, u32x4& r2, u32x4& r3) {
            j = j < ntiles ? j : ntiles - 1;
            const bool cch = j < ncache;
            const char* kc = (const char*)(ck + (size_t)(j * 64 + skey) * 64 + sds * 8); const char* vc = (const char*)(cv + (size_t)(j * 64 + skey) * 64 + sds * 8);
            const char* kpj = (const char*)(proj + (size_t)(rowbase + (j - ncache) * 64 + skey) * ODD_IN + hk * 64 + sds * 8 + 1024);
            const char* p0 = cch ? kc : kpj; const char* p1 = cch ? kc + 16 : kpj; const char* p2 = cch ? vc : kpj + 512; const char* p3 = cch ? vc + 16 : kpj + 512;
            r0 = *(const u32x4*)p0; r1 = *(const u32x4*)p1; r2 = *(const u32x4*)p2; r3 = *(const u32x4*)p3;
        };
        auto lstore = [&](int j, int buf, const u32x4 r0, const u32x4 r1, const u32x4 r2, const u32x4 r3) {
            u32x4 kreg, vreg;
            if (j < ncache) {
                kreg.x = cvt_pk_bf16(__uint_as_float(r0.x), __uint_as_float(r0.y)); kreg.y = cvt_pk_bf16(__uint_as_float(r0.z), __uint_as_float(r0.w));
                kreg.z = cvt_pk_bf16(__uint_as_float(r1.x), __uint_as_float(r1.y)); kreg.w = cvt_pk_bf16(__uint_as_float(r1.z), __uint_as_float(r1.w));
                vreg.x = cvt_pk_bf16(__uint_as_float(r2.x), __uint_as_float(r2.y)); vreg.y = cvt_pk_bf16(__uint_as_float(r2.z), __uint_as_float(r2.w));
                vreg.z = cvt_pk_bf16(__uint_as_float(r3.x), __uint_as_float(r3.y)); vreg.w = cvt_pk_bf16(__uint_as_float(r3.z), __uint_as_float(r3.w));
            } else { kreg = r0; vreg = r2; }
            *(LAS u32x4*)(lds + buf * AT_KB + pg8::lds_byte(skey, sds * 8)) = kreg;
            LAS bf16_t* vt = (LAS bf16_t*)(lds + 2 * AT_KB + buf * AT_KB);
            vt[(sds * 8 + 0) * AT_KS + (skey ^ (sds << 3))] = (bf16_t)(vreg.x & 0xffff); vt[(sds * 8 + 1) * AT_KS + (skey ^ (sds << 3))] = (bf16_t)(vreg.x >> 16);
            vt[(sds * 8 + 2) * AT_KS + (skey ^ (sds << 3))] = (bf16_t)(vreg.y & 0xffff); vt[(sds * 8 + 3) * AT_KS + (skey ^ (sds << 3))] = (bf16_t)(vreg.y >> 16);
            vt[(sds * 8 + 4) * AT_KS + (skey ^ (sds << 3))] = (bf16_t)(vreg.z & 0xffff); vt[(sds * 8 + 5) * AT_KS + (skey ^ (sds << 3))] = (bf16_t)(vreg.z >> 16);
            vt[(sds * 8 + 6) * AT_KS + (skey ^ (sds << 3))] = (bf16_t)(vreg.w & 0xffff); vt[(sds * 8 + 7) * AT_KS + (skey ^ (sds << 3))] = (bf16_t)(vreg.w >> 16);
        };
        auto compute = [&](int buf) {
            const LAS unsigned char* kb = lds + buf * AT_KB; const LAS unsigned char* vb = lds + 2 * AT_KB + buf * AT_KB;
            f32x4 s[4][2];
#pragma unroll
            for (int mt = 0; mt < 4; ++mt) {
                s[mt][0] = (f32x4){0.f, 0.f, 0.f, 0.f}; s[mt][1] = (f32x4){0.f, 0.f, 0.f, 0.f};
#pragma unroll
                for (int ks = 0; ks < 2; ++ks) { const bf16x8 a = *(const LAS bf16x8*)(kb + pg8::lds_byte(mt * 16 + l15, ks * 32 + q4 * 8));
                    s[mt][0] = __builtin_amdgcn_mfma_f32_16x16x32_bf16(a, qf[0][ks], s[mt][0], 0, 0, 0);
                    s[mt][1] = __builtin_amdgcn_mfma_f32_16x16x32_bf16(a, qf[1][ks], s[mt][1], 0, 0, 0); }
            }
            bf16x8 pf[2][2];
#pragma unroll
            for (int nt = 0; nt < 2; ++nt)
#pragma unroll
                for (int kp = 0; kp < 2; ++kp) { float e[8];
#pragma unroll
                    for (int i = 0; i < 4; ++i) { e[i] = __builtin_amdgcn_exp2f(s[2 * kp][nt][i]); e[4 + i] = __builtin_amdgcn_exp2f(s[2 * kp + 1][nt][i]); }
                    u32x4 w; w.x = cvt_pk_bf16(e[0], e[1]); w.y = cvt_pk_bf16(e[2], e[3]); w.z = cvt_pk_bf16(e[4], e[5]); w.w = cvt_pk_bf16(e[6], e[7]);
                    pf[nt][kp] = __builtin_bit_cast(bf16x8, w); }
            { const u32x4 ones_ = {0x3F803F80u, 0x3F803F80u, 0x3F803F80u, 0x3F803F80u}; const bf16x8 ones = __builtin_bit_cast(bf16x8, ones_);
#pragma unroll
              for (int nt = 0; nt < 2; ++nt)
#pragma unroll
                  for (int kp = 0; kp < 2; ++kp) lsumv[nt] = __builtin_amdgcn_mfma_f32_16x16x32_bf16(ones, pf[nt][kp], lsumv[nt], 0, 0, 0); }
#pragma unroll
            for (int mt = 0; mt < 4; ++mt)
#pragma unroll
                for (int kp = 0; kp < 2; ++kp) { const int vsw = ((2 * mt + (l15 >> 3)) & 7) << 3; const u32x2 a0 = *(const LAS u32x2*)(vb + ((mt * 16 + l15) * AT_KS + ((kp * 32 + q4 * 4) ^ vsw)) * 2), a1 = *(const LAS u32x2*)(vb + ((mt * 16 + l15) * AT_KS + ((kp * 32 + 16 + q4 * 4) ^ vsw)) * 2);
                    const u32x4 au = {a0.x, a0.y, a1.x, a1.y}; const bf16x8 a = __builtin_bit_cast(bf16x8, au);
                    O[mt][0] = __builtin_amdgcn_mfma_f32_16x16x32_bf16(a, pf[0][kp], O[mt][0], 0, 0, 0);
                    O[mt][1] = __builtin_amdgcn_mfma_f32_16x16x32_bf16(a, pf[1][kp], O[mt][1], 0, 0, 0); }
        };
#define AT_BAR() do { asm volatile("s_waitcnt lgkmcnt(0)" ::: "memory"); __builtin_amdgcn_s_barrier(); asm volatile("" ::: "memory"); } while (0)
        __syncthreads();
        gload(0, ra0, ra1, ra2, ra3); lstore(0, 0, ra0, ra1, ra2, ra3); gload(1, rb0, rb1, rb2, rb3);
        AT_BAR();
        for (int j = 0; j < ntiles; j += 2) {
            gload(j + 2, ra0, ra1, ra2, ra3);
            compute(0);
            lstore(j + 1, 1, rb0, rb1, rb2, rb3);
            AT_BAR();
            gload(j + 3, rb0, rb1, rb2, rb3);
            compute(1);
            if (j + 2 < ntiles) lstore(j + 2, 0, ra0, ra1, ra2, ra3);
            AT_BAR();
        }
#undef AT_BAR
#pragma unroll
        for (int nt = 0; nt < 2; ++nt) {
            const float inv = 1.0f / lsumv[nt][0];
            const size_t row = (size_t)(rowbase + tok0 + nt * 16 + l15);
            u32x2 gvv[4];
#pragma unroll
            for (int mt = 0; mt < 4; ++mt) gvv[mt] = *(const u32x2*)(proj + row * ODD_IN + 1536 + qh * 64 + mt * 16 + q4 * 4);
#pragma unroll
            for (int mt = 0; mt < 4; ++mt) { const int col = qh * 64 + mt * 16 + q4 * 4;
                const u32x2 gv = gvv[mt];
                const float o0 = O[mt][nt][0] * inv * siluf_(bflo(gv.x)), o1 = O[mt][nt][1] * inv * siluf_(bfhi(gv.x)), o2 = O[mt][nt][2] * inv * siluf_(bflo(gv.y)), o3 = O[mt][nt][3] * inv * siluf_(bfhi(gv.y));
                u32x2 w; w.x = cvt_pk_bf16(o0, o1); w.y = cvt_pk_bf16(o2, o3); *(u32x2*)(mix + row * DM + col) = w; }
        }
    }
}

__global__ void __launch_bounds__(NTHREADS, 2) fwd_megakernel(Params P) {
    extern __shared__ __attribute__((aligned(16))) unsigned char lds_raw[];
    LAS unsigned char* lds = (LAS unsigned char*)lds_raw;
    cg::grid_group grid = cg::this_grid();
    const int G = gridDim.x;
    unsigned* barw = (unsigned*)(P.ws + WS_BAR);
    volatile LAS unsigned* xst = (volatile LAS unsigned*)(lds + 131072);
    if (threadIdx.x < 4) xst[threadIdx.x] = 0u;
    __syncthreads();
    const XcdBarrier xbar = xcd_barrier_post(barw, xst);
    if (P.out == nullptr) grid.sync();
#define GSYNC() xcd_barrier(xbar)
#ifndef SKIP_P0
    p0_phase(P, lds);
#endif
    GSYNC();
#pragma nounroll
    for (int L = 0; L < 4; ++L) {
#ifdef DBL_SYNC
        for (int q = 0; q < 5; ++q) GSYNC();
#endif
        const int p = L >> 1; const bool even = (L & 1) == 0;
        if (L == 0) { modulate_phase(P, 0); GSYNC(); }
        {
            const int N = even ? EVEN_IN : ODD_IN;
            const bf16_t* Bt = even ? (const bf16_t*)(P.ws + WS_WINE) + (size_t)p * EVEN_IN * 1024 : (const bf16_t*)(P.ws + WS_WINO) + (size_t)p * ODD_IN * 1024;
            pg8::Gemm g{(const bf16_t*)(P.ws + WS_HMIX), Bt, NTOK, N, 1024}; pg8::StaticOrder S; S.init(NTOK, N, G, (int)blockIdx.x);
            pg8::EpiBf16 E{(bf16_t*)(P.ws + WS_PROJ), N};
#ifndef SKIP_G1
            pg8::gemm_phase<pg8::EpiBf16>(lds, g, S, E);
#endif
            { const int bx = (int)blockIdx.x;
              if (L == 0 && bx >= 64) { tr_range(P, lds, 2176, 2432, bx - 64, G - 64); tr_range(P, lds, 2688, 3328, bx - 64, G - 64); tr_range(P, lds, 3968, 4224, bx - 64, G - 64); }
              else if (L == 1 && bx >= 128) tr_range(P, lds, 1088, 2176, bx - 128, G - 128);
              else if (L == 2 && bx >= 64) { tr_range(P, lds, 2432, 2688, bx - 64, G - 64); tr_range(P, lds, 3328, 3968, bx - 64, G - 64); tr_range(P, lds, 4224, 4480, bx - 64, G - 64); } }
#ifdef DBL_G1
            GSYNC(); pg8::gemm_phase<pg8::EpiBf16>(lds, g, S, E);
#endif
        }
        GSYNC();
        if (even) {
#ifndef SKIP_SCAN
            scan_phase(P, lds, p);
#endif
#ifdef DBL_SCAN
            GSYNC(); scan_phase(P, lds, p);
#endif
            GSYNC();
#ifndef SKIP_POST
            even_post_phase(P, p);
#endif
#ifdef DBL_MISC
            GSYNC(); even_post_phase(P, p);
#endif
        } else {
#ifndef SKIP_QK
            qknorm_phase(P, p);
#endif
            GSYNC();
#ifndef SKIP_ATT
            attn_phase(P, lds, p);
#endif
#ifdef DBL_ATT
            GSYNC(); attn_phase(P, lds, p);
#endif
        }
        GSYNC();
        {
            const bf16_t* Bt = even ? (const bf16_t*)(P.ws + WS_WOUTE) + (size_t)p * 1024 * 1024 : (const bf16_t*)(P.ws + WS_WOUTO) + (size_t)p * 1024 * 1024;
            pg8::Gemm g{(const bf16_t*)(P.ws + WS_HMIX), Bt, NTOK, 1024, 1024}; pg8::StaticOrder S; S.init(NTOK, 1024, G, (int)blockIdx.x);
            pg8::EpiFuse E{L == 0 ? P.x_prompt : P.out, L == 0 ? P.x_sample : P.out + (size_t)NPR * DM, P.out, (const float*)(P.ws + WS_MOD) + (size_t)L * 9 * 3072,
                           L < 3 ? (bf16_t*)(P.ws + WS_HMIX) : nullptr, P.norm_g + (L < 3 ? L + 1 : 0) * 1024, (const float*)(P.ws + WS_MOD) + (size_t)(L < 3 ? L + 1 : 0) * 9 * 3072,
                           P.final_g, (float*)(P.ws + WS_XSLOT), (unsigned*)(P.ws + WS_XCNT) + (size_t)L * 64 * 64};
            pg8::gemm_phase<pg8::EpiFuse>(lds, g, S, E);
        }
        if (L < 3) GSYNC();
    }
}

extern "C" void kernel_launch(void* const* d_in, const int* in_sizes, int n_in, void* d_out, int out_size, void* d_ws, size_t ws_size, hipStream_t stream) {
    static int grid = 0;
    if (grid == 0) {
        if (n_in != 29 || ws_size < WS_END) { fprintf(stderr, "kernel_launch: unexpected n_in %d or ws_size %zu (< %zu)\n", n_in, ws_size, (size_t)WS_END); grid = -1; return; }
        int dev = 0, cus = 0, per_cu = 0;
        hipGetDevice(&dev); hipDeviceGetAttribute(&cus, hipDeviceAttributeMultiprocessorCount, dev);
        if (hipFuncSetAttribute((const void*)fwd_megakernel, hipFuncAttributeMaxDynamicSharedMemorySize, LDS_BYTES) != hipSuccess) { fprintf(stderr, "hipFuncSetAttribute failed\n"); grid = -1; return; }
        hipOccupancyMaxActiveBlocksPerMultiprocessor(&per_cu, (const void*)fwd_megakernel, NTHREADS, LDS_BYTES);
        if (per_cu < 1) { fprintf(stderr, "occupancy query says %d blocks per CU\n", per_cu); per_cu = 1; }
        (void)hipGetLastError();
        grid = cus;
    }
    if (grid < 0) return;
    if (hipMemsetAsync((char*)d_ws + WS_BAR, 0, 16384 + 4 * 64 * 256, stream) != hipSuccess) { fprintf(stderr, "hipMemsetAsync of the barrier words failed\n"); return; }
    Params p{};
    const float** pp = (const float**)&p;
    for (int i = 0; i < 29; ++i) pp[i] = (const float*)d_in[i];
    p.out = (float*)d_out; p.ws = (unsigned char*)d_ws;
    void* args[] = {&p};
    hipError_t e = hipLaunchCooperativeKernel((const void*)fwd_megakernel, dim3(grid), dim3(NTHREADS), args, LDS_BYTES, stream);
    if (e != hipSuccess) fprintf(stderr, "cooperative launch failed: %s (grid %d)\n", hipGetErrorString(e), grid);
}
```

```cpp
#include <hip/hip_runtime.h>
#include <hip/hip_cooperative_groups.h>
#include <cstdio>
namespace cg = cooperative_groups;

#define LAS __attribute__((address_space(3)))
typedef unsigned short bf16_t;
typedef short bf16x8 __attribute__((ext_vector_type(8)));
typedef float f32x4 __attribute__((ext_vector_type(4)));
typedef float f32x2 __attribute__((ext_vector_type(2)));
typedef unsigned u32x4 __attribute__((ext_vector_type(4)));
typedef unsigned u32x2 __attribute__((ext_vector_type(2)));

constexpr int DM = 1024, NTOK = 16384, NPR = 8192;
constexpr int EVEN_IN = 4352, ODD_IN = 2560;
constexpr int NTHREADS = 512;
constexpr int LDS_BYTES = 131072 + 16;
constexpr size_t OUT_Y = 0, OUT_STATE = 2ull * 8388608, OUT_CK = OUT_STATE + 4194304, OUT_CV = OUT_CK + 4194304;

constexpr size_t WS_WINE = 0;
constexpr size_t WS_WOUTE = WS_WINE + 2ull * EVEN_IN * 1024 * 2;
constexpr size_t WS_WINO = WS_WOUTE + 2ull * 1024 * 1024 * 2;
constexpr size_t WS_WOUTO = WS_WINO + 2ull * ODD_IN * 1024 * 2;
constexpr size_t WS_MOD = WS_WOUTO + 2ull * 1024 * 1024 * 2;
constexpr size_t WS_ROPE = WS_MOD + 4ull * 9 * 3072 * 4;
constexpr size_t WS_BS = WS_ROPE + 16384;
constexpr size_t WS_HMIX = WS_BS + 2ull * NTOK * 8 * 4;
constexpr size_t WS_PROJ = WS_HMIX + (size_t)NTOK * 1024 * 2;
constexpr size_t WS_Y = WS_PROJ + (size_t)NTOK * EVEN_IN * 2;
constexpr size_t WS_BAR = WS_Y + 2ull * NTOK * 512 * 2;
constexpr size_t WS_XCNT = WS_BAR + 16384;
constexpr size_t WS_XSLOT = WS_XCNT + 4ull * 64 * 256;
constexpr size_t WS_END = WS_XSLOT + 64ull * 256 * 4 * 4;

struct Params {
    const float* x_prompt; const float* x_sample; const float* c; const float* state_rwkv; const float* cache_k; const float* cache_v;
    const float* c_ctx; const float* w_ada; const float* b_ada; const float* norm_g; const float* final_g; const float* w_in_e;
    const float* mu_shift; const float* lora_w2; const float* w0; const float* lora_a2; const float* a0; const float* k_k; const float* k_a;
    const float* r_k; const float* lnx_g; const float* lnx_b; const float* conv_w; const float* conv_b; const float* w_out_e;
    const float* w_in_o; const float* q_norm_g; const float* k_norm_g; const float* w_out_o;
    float* out; unsigned char* ws;
};

__device__ __forceinline__ float bf2f(unsigned v) { return __uint_as_float(v << 16); }
__device__ __forceinline__ float bflo(unsigned v) { return __uint_as_float(v << 16); }
__device__ __forceinline__ float bfhi(unsigned v) { return __uint_as_float(v & 0xffff0000u); }
__device__ __forceinline__ unsigned cvt_pk_bf16(float lo, float hi) { unsigned r; asm volatile("v_cvt_pk_bf16_f32 %0, %1, %2" : "=v"(r) : "v"(lo), "v"(hi)); return r; }
__device__ __forceinline__ float sigmoidf_(float x) { return __builtin_amdgcn_rcpf(1.0f + __expf(-x)); }
__device__ __forceinline__ float tanhf_(float x) { return 2.0f * __builtin_amdgcn_rcpf(1.0f + __expf(-2.0f * x)) - 1.0f; }
__device__ __forceinline__ float siluf_(float x) { return x * __builtin_amdgcn_rcpf(1.0f + __expf(-x)); }
__device__ __forceinline__ int otid() { int t = threadIdx.x; asm volatile("" : "+v"(t)); return t; }
template <int CTRL> __device__ __forceinline__ float dpp_add(float x) {
    return x + __builtin_bit_cast(float, __builtin_amdgcn_update_dpp(0, __builtin_bit_cast(int, x), CTRL, 0xf, 0xf, true));
}
__device__ __forceinline__ float allred4(float x) { x = dpp_add<0xB1>(x); x = dpp_add<0x4E>(x); return x; }
__device__ __forceinline__ float allred8(float x) { x = dpp_add<0x141>(x); x = dpp_add<0xB1>(x); x = dpp_add<0x4E>(x); return x; }
__device__ __forceinline__ float allred16(float x) { x = allred8(x); x = dpp_add<0x128>(x); return x; }
__device__ __forceinline__ float allred64(float x) { x = allred16(x); x += __shfl_xor(x, 16); x += __shfl_xor(x, 32); return x; }

#define XB_TMO      128
#define XB_XCNT(j)  (256  + 64 * (j))
#define XB_XSUB(j)  (1280 + 64 * (j))
#define XB_XGEN(j)  (2304 + 64 * (j))
#define XB_TOP      3328
#define XB_TOPGEN   3392
#define XCD_BAR_WORDS 3456
#define XB_SPIN_CAP (1u << 22)
__device__ __forceinline__ unsigned xb_ld(unsigned* p)              { return __hip_atomic_load(p, __ATOMIC_RELAXED, __HIP_MEMORY_SCOPE_AGENT); }
__device__ __forceinline__ unsigned xb_add(unsigned* p, unsigned v) { return __hip_atomic_fetch_add(p, v, __ATOMIC_RELAXED, __HIP_MEMORY_SCOPE_AGENT); }
__device__ __forceinline__ unsigned xb_xcc_id() { return (unsigned)__builtin_amdgcn_s_getreg((3 << 11) | 20) & 0xFu; }
#define XB_SPIN(cond, bar) do { unsigned _sp = 0; while (cond) { __builtin_amdgcn_s_sleep(1); \
    if ((++_sp & 255u) == 0u) { if (xb_ld(&(bar)[XB_TMO])) break; if (_sp > XB_SPIN_CAP) { atomicAdd(&(bar)[XB_TMO], 1u); break; } } } } while (0)
struct XcdBarrier { unsigned* bar; unsigned x; volatile LAS unsigned* st; };
__device__ __forceinline__ XcdBarrier xcd_barrier_post(unsigned* bar, volatile LAS unsigned* st) {
    XcdBarrier b; b.bar = bar; b.x = xb_xcc_id(); b.st = st;
    if (threadIdx.x == 0) (void)xb_add(&bar[XB_XCNT(b.x)], 1u);
    return b;
}
__device__ __forceinline__ void xcd_barrier_complete(unsigned* bar, unsigned x, unsigned& nloc, unsigned& nx) {
    const unsigned G = gridDim.x * gridDim.y * gridDim.z;
    unsigned sum, cnt, mine, sp = 0u;
    for (;;) {
        sum = 0u; cnt = 0u; mine = 0u;
#pragma unroll
        for (unsigned j = 0; j < 16; ++j) { const unsigned c = xb_ld(&bar[XB_XCNT(j)]); sum += c; cnt += (c > 0u) ? 1u : 0u; mine = (j == x) ? c : mine; }
        if (sum == G) break;
        __builtin_amdgcn_s_sleep(1);
        if ((++sp & 255u) == 0u) { if (xb_ld(&bar[XB_TMO])) break; if (sp > XB_SPIN_CAP) { atomicAdd(&bar[XB_TMO], 1u); break; } }
    }
    nloc = mine > 0u ? mine : 1u; nx = cnt > 0u ? cnt : 1u;
}
__device__ __forceinline__ void xcd_barrier(const XcdBarrier& b) {
    asm volatile("s_waitcnt vmcnt(0)" ::: "memory");
    __syncthreads();
    if (threadIdx.x == 0) {
        unsigned* bar = b.bar;
        __builtin_amdgcn_s_waitcnt(0);
        unsigned nloc = b.st[0], nx = b.st[1];
        if (nloc == 0u) { xcd_barrier_complete(bar, b.x, nloc, nx); b.st[0] = nloc; b.st[1] = nx; }
        const unsigned old = xb_add(&bar[XB_XSUB(b.x)], 1u);
        const unsigned gen = old / nloc;
        if (old + 1u == (gen + 1u) * nloc) {
            __builtin_amdgcn_fence(__ATOMIC_RELEASE, "agent");
            asm volatile("s_waitcnt vmcnt(0)" ::: "memory");
            const unsigned og = xb_add(&bar[XB_TOP], 1u);
            const unsigned tg = og / nx;
            if (og + 1u == (tg + 1u) * nx) xb_add(&bar[XB_TOPGEN], 1u);
            else XB_SPIN(xb_ld(&bar[XB_TOPGEN]) == tg, bar);
            __builtin_amdgcn_fence(__ATOMIC_ACQUIRE, "agent");
            xb_add(&bar[XB_XGEN(b.x)], 1u);
            asm volatile("s_waitcnt vmcnt(0)" ::: "memory");
        } else {
            XB_SPIN(xb_ld(&bar[XB_XGEN(b.x)]) == gen, bar);
            __builtin_amdgcn_fence(__ATOMIC_ACQUIRE, "agent");
            asm volatile("s_waitcnt vmcnt(0)" ::: "memory");
        }
    }
    __syncthreads();
}

namespace pg8 {
constexpr int BM = 256, BK = 64, HALF = 128, HTB = HALF * BK * 2, NXCD = 8, WGM = 8;
__device__ __forceinline__ int lds_byte(int r, int c) { const int st = (r >> 4) * 2 + (c >> 5), rr = r & 15, cc = c & 31, ob = rr * 64 + cc * 2; return st * 1024 + (ob ^ (((ob >> 9) & 1) << 5)); }
__device__ __forceinline__ void stage_rc(int b, int& R, int& C) { const int st = b / 1024, sb = b % 1024, swz = sb ^ (((sb >> 9) & 1) << 5); R = (st >> 1) * 16 + swz / 64; C = (st & 1) * 32 + (swz % 64) / 2; }
__device__ __forceinline__ int perm32(int rho) { const int n = rho >> 4, i = rho & 15; return 8 * (i >> 2) + 4 * n + (i & 3); }
struct Unit { int pm, pn; };
struct Gemm { const bf16_t* A; const bf16_t* Bt; int M, N, K; };
struct StaticOrder {
    int nM, nN, nwg, G, c;
    __device__ void init(int M, int N, int G_, int c_) { nM = M / BM; nN = N / BM; nwg = nM * nN; G = G_; c = c_; }
    __device__ bool next(int i, Unit& u) const {
        const long L = (long)i * G + c; if (L >= nwg) return false;
        int wgid = (int)L; { const int q = nwg / NXCD, r = nwg % NXCD, xcd = wgid % NXCD, off = wgid / NXCD; wgid = (xcd < r ? xcd * (q + 1) : r * (q + 1) + (xcd - r) * q) + off; }
        const int nig = WGM * nN, gid = wgid / nig, fm = gid * WGM, gsz = (nM - fm) < WGM ? (nM - fm) : WGM;
        u.pm = fm + ((wgid % nig) % gsz); u.pn = (wgid % nig) / gsz; return true;
    }
};
struct EpiBf16 {
    static constexpr bool PERM = true, AFTER_DRAIN = false;
    bf16_t* O; int ldc;
    __device__ __forceinline__ void operator()(const f32x4 (&acc)[2][2][4][2], const Unit& u, int wr, int wc, int fr, int fq) const {
        const int row0 = u.pm * BM + wr * 64 + fr; const int col0 = u.pn * BM + wc * 32 + 8 * fq;
#pragma unroll
        for (int ai = 0; ai < 2; ++ai)
#pragma unroll
            for (int m = 0; m < 4; ++m) { bf16_t* rowp = O + (size_t)(row0 + ai * HALF + m * 16) * ldc + col0;
#pragma unroll
                for (int bj = 0; bj < 2; ++bj) { const f32x4 v0 = acc[ai][bj][m][0], v1 = acc[ai][bj][m][1];
                    u32x4 w; w.x = cvt_pk_bf16(v0[0], v0[1]); w.y = cvt_pk_bf16(v0[2], v0[3]); w.z = cvt_pk_bf16(v1[0], v1[1]); w.w = cvt_pk_bf16(v1[2], v1[3]);
                    *(u32x4*)(rowp + bj * HALF) = w; } }
    }
};
struct EpiResGate {
    static constexpr bool PERM = false, AFTER_DRAIN = false;
    const float* xp; const float* xs; float* xo; const float* modl;
    __device__ __forceinline__ void operator()(const f32x4 (&acc)[2][2][4][2], const Unit& u, int wr, int wc, int fr, int fq) const {
        const int row0 = u.pm * BM + wr * 64 + fr, col0 = u.pn * BM + wc * 32 + 4 * fq;
        const int mi = (u.pm < 32) ? 0 : 1 + ((u.pm - 32) >> 2);
        const float* gp = modl + mi * 3072 + 2048 + col0;
        f32x4 gv[2][2];
#pragma unroll
        for (int bj = 0; bj < 2; ++bj)
#pragma unroll
            for (int n = 0; n < 2; ++n) gv[bj][n] = *(const f32x4*)(gp + bj * HALF + n * 16);
#pragma unroll
        for (int ai = 0; ai < 2; ++ai)
#pragma unroll
            for (int m = 0; m < 4; ++m) { const int row = row0 + ai * HALF + m * 16;
                const float* src = (row < NPR ? xp + (size_t)row * DM : xs + (size_t)(row - NPR) * DM) + col0; float* dst = xo + (size_t)row * DM + col0;
                f32x4 xv[2][2];
#pragma unroll
                for (int bj = 0; bj < 2; ++bj)
#pragma unroll
                    for (int n = 0; n < 2; ++n) xv[bj][n] = *(const f32x4*)(src + bj * HALF + n * 16);
#pragma unroll
                for (int bj = 0; bj < 2; ++bj)
#pragma unroll
                    for (int n = 0; n < 2; ++n) *(f32x4*)(dst + bj * HALF + n * 16) = xv[bj][n] + gv[bj][n] * acc[ai][bj][m][n]; }
    }
};

struct EpiFuse {
    static constexpr bool PERM = true, AFTER_DRAIN = true;
    const float* xp; const float* xs; float* xo; const float* modl;
    bf16_t* hout; const float* gn; const float* modn;
    const float* fing;
    float* xslots; unsigned* cnt;
    __device__ __forceinline__ void fused(f32x4 (&acc)[2][2][4][2], const Unit& u, int wr, int wc, int fr, int fq, LAS unsigned char* lds, int wid, int lane) const {
        const int tid = wid * 64 + lane;
        const int row0 = u.pm * BM + wr * 64 + fr, col0 = u.pn * BM + wc * 32 + 8 * fq;
        const int mi = (u.pm < 32) ? 0 : 1 + ((u.pm - 32) >> 2);
        LAS float* Pt = (LAS float*)lds;
        LAS float* St = (LAS float*)(lds + 4096);
        {
            const float* gp = modl + mi * 3072 + 2048 + col0;
            f32x4 gv[2][2];
#pragma unroll
            for (int bj = 0; bj < 2; ++bj)
#pragma unroll
                for (int n = 0; n < 2; ++n) gv[bj][n] = *(const f32x4*)(gp + bj * HALF + n * 4);
#pragma unroll
            for (int ai = 0; ai < 2; ++ai)
#pragma unroll
                for (int m = 0; m < 4; ++m) { const int row = row0 + ai * HALF + m * 16;
                    const float* src = (row < NPR ? xp + (size_t)row * DM : xs + (size_t)(row - NPR) * DM) + col0;
                    float ss = 0.f;
#pragma unroll
                    for (int bj = 0; bj < 2; ++bj)
#pragma unroll
                        for (int n = 0; n < 2; ++n) { const f32x4 xn = *(const f32x4*)(src + bj * HALF + n * 4) + gv[bj][n] * acc[ai][bj][m][n]; acc[ai][bj][m][n] = xn;
                            ss += xn[0] * xn[0] + xn[1] * xn[1] + xn[2] * xn[2] + xn[3] * xn[3]; }
                    ss += __shfl_xor(ss, 16); ss += __shfl_xor(ss, 32);
                    if (fq == 0) Pt[(ai * HALF + wr * 64 + m * 16 + fr) * 4 + wc] = ss; }
        }
        asm volatile("s_waitcnt lgkmcnt(0)" ::: "memory"); __builtin_amdgcn_s_barrier(); asm volatile("" ::: "memory");
        if (tid < 256) { const f32x4 p4 = *(const LAS f32x4*)(Pt + tid * 4);
            __hip_atomic_store(xslots + ((size_t)u.pm * 256 + tid) * 4 + u.pn, (p4[0] + p4[1]) + (p4[2] + p4[3]), __ATOMIC_RELAXED, __HIP_MEMORY_SCOPE_AGENT); }
        asm volatile("s_waitcnt vmcnt(0)" ::: "memory");
        if (tid < 256 && lane == 0) __hip_atomic_fetch_add(cnt + 64 * u.pm, 1u, __ATOMIC_RELAXED, __HIP_MEMORY_SCOPE_AGENT);
        if (wid == 0) { unsigned sp = 0;
            while ((unsigned)__builtin_amdgcn_readfirstlane(__hip_atomic_load(cnt + 64 * u.pm, __ATOMIC_RELAXED, __HIP_MEMORY_SCOPE_AGENT)) < 16u) { __builtin_amdgcn_s_sleep(1); if (++sp > (1u << 24)) break; }
            __builtin_amdgcn_fence(__ATOMIC_ACQUIRE, "agent"); }
        asm volatile("s_waitcnt vmcnt(0) lgkmcnt(0)" ::: "memory"); __builtin_amdgcn_s_barrier(); asm volatile("" ::: "memory");
        if (tid < 256) { const float* sl = xslots + ((size_t)u.pm * 256 + tid) * 4; float tot = 0.f;
#pragma unroll
            for (int t = 0; t < 4; ++t) tot += __hip_atomic_load(sl + t, __ATOMIC_RELAXED, __HIP_MEMORY_SCOPE_AGENT);
            St[tid] = rsqrtf(tot * (1.0f / 1024.0f) + 1e-6f); }
        asm volatile("s_waitcnt lgkmcnt(0)" ::: "memory"); __builtin_amdgcn_s_barrier(); asm volatile("" ::: "memory");
        f32x4 cs[2][2], sh[2][2];
#pragma unroll
        for (int bj = 0; bj < 2; ++bj)
#pragma unroll
            for (int n = 0; n < 2; ++n) { const int c = col0 + bj * HALF + n * 4;
                if (hout) { cs[bj][n] = *(const f32x4*)(gn + c) * (*(const f32x4*)(modn + mi * 3072 + 1024 + c) + 1.0f); sh[bj][n] = *(const f32x4*)(modn + mi * 3072 + c); }
                else { cs[bj][n] = *(const f32x4*)(fing + c); sh[bj][n] = (f32x4){0.f, 0.f, 0.f, 0.f}; } }
#pragma unroll
        for (int ai = 0; ai < 2; ++ai)
#pragma unroll
            for (int m = 0; m < 4; ++m) { const int rl = ai * HALF + wr * 64 + m * 16 + fr; const int row = u.pm * BM + rl; const float rs = St[rl];
                float* dst = xo + (size_t)row * DM + col0;
#pragma unroll
                for (int bj = 0; bj < 2; ++bj) { const f32x4 x0 = acc[ai][bj][m][0], x1 = acc[ai][bj][m][1]; const f32x4 h0 = x0 * rs * cs[bj][0] + sh[bj][0], h1 = x1 * rs * cs[bj][1] + sh[bj][1];
                    if (hout) { *(f32x4*)(dst + bj * HALF) = x0; *(f32x4*)(dst + bj * HALF + 4) = x1;
                        u32x4 w; w.x = cvt_pk_bf16(h0[0], h0[1]); w.y = cvt_pk_bf16(h0[2], h0[3]); w.z = cvt_pk_bf16(h1[0], h1[1]); w.w = cvt_pk_bf16(h1[2], h1[3]); *(u32x4*)(hout + (size_t)row * DM + col0 + bj * HALF) = w; }
                    else { *(f32x4*)(dst + bj * HALF) = h0; *(f32x4*)(dst + bj * HALF + 4) = h1; } } }
    }
};

template <class Epi>
__device__ __forceinline__ void gemm_phase(LAS unsigned char* lds, const Gemm g, const StaticOrder& S, const Epi& E) {
    const int tid = otid(), wid = __builtin_amdgcn_readfirstlane(tid >> 6), lane = tid & 63, wr = wid >> 2, wc = wid & 3, fr = lane & 15, fq = lane >> 4;
    const int K = g.K, nt = K / BK;
    unsigned voffA[2], voffB[2];
#pragma unroll
    for (int i = 0; i < 2; ++i) { int R, C; stage_rc(tid * 16 + i * 8192, R, C); const int Rb = Epi::PERM ? ((R & ~31) + perm32(R & 31)) : R;
        voffA[i] = (unsigned)(R * K + C) * 2u; voffB[i] = (unsigned)(Rb * K + C) * 2u; }
    const size_t kstep = (size_t)(BK * 2);
    const size_t hstep = (size_t)HALF * K * 2;
    const size_t tstep = 2 * hstep;
    const unsigned ldsw = (unsigned)wid * 1024u;
    const int aoff = lds_byte(wr * 64 + fr, fq * 8), boff = lds_byte(wc * 32 + fr, fq * 8);
#define PG8_SA(b, h) (((b) * 2 + (h)) * HTB)
#define PG8_SB(b, h) ((4 + (b) * 2 + (h)) * HTB)
#define PG8_STAGE(bufoff, gbase, voff) do { _Pragma("unroll") for (int _i = 0; _i < 2; ++_i) \
        __builtin_amdgcn_global_load_lds((const unsigned*)((const char*)(gbase) + (voff)[_i]), (LAS unsigned*)(lds + (bufoff) + ldsw + _i * 8192), 16, 0, 0); } while (0)
#define PG8_LDA(dst, b, h) do { _Pragma("unroll") for (int m = 0; m < 4; ++m) _Pragma("unroll") for (int k = 0; k < 2; ++k) dst[m][k] = *(const LAS bf16x8*)(lds + PG8_SA(b, h) + aoff + m * 2048 + k * 1024); } while (0)
#define PG8_LDB(dst, b, h) do { _Pragma("unroll") for (int n = 0; n < 2; ++n) _Pragma("unroll") for (int k = 0; k < 2; ++k) dst[n][k] = *(const LAS bf16x8*)(lds + PG8_SB(b, h) + boff + n * 2048 + k * 1024); } while (0)
#define PG8_MMA(ai, bj, At, Bt) do { __builtin_amdgcn_s_setprio(1); _Pragma("unroll") for (int m = 0; m < 4; ++m) _Pragma("unroll") for (int n = 0; n < 2; ++n) _Pragma("unroll") for (int k = 0; k < 2; ++k) \
        acc[ai][bj][m][n] = __builtin_amdgcn_mfma_f32_16x16x32_bf16(Bt[n][k], At[m][k], acc[ai][bj][m][n], 0, 0, 0); __builtin_amdgcn_s_setprio(0); } while (0)
#define PG8_WAIT_V(n) asm volatile("s_waitcnt vmcnt(" #n ")" ::: "memory")
#define PG8_WAIT_L(n) asm volatile("s_waitcnt lgkmcnt(" #n ")" ::: "memory")
#define PG8_BAR __builtin_amdgcn_s_barrier()
#define PG8_SCHED __builtin_amdgcn_sched_barrier(0)
    Unit cur, nxt; int ui = 0;
    if (!S.next(0, cur)) return;
    f32x4 acc[2][2][4][2];
#pragma unroll
    for (int a = 0; a < 2; ++a)
#pragma unroll
        for (int b = 0; b < 2; ++b)
#pragma unroll
            for (int m = 0; m < 4; ++m)
#pragma unroll
                for (int n = 0; n < 2; ++n) acc[a][b][m][n] = (f32x4){0.f, 0.f, 0.f, 0.f};
    bf16x8 At[4][2], B0[2][2], B1[2][2];
    const char* cA = (const char*)g.A + (size_t)cur.pm * tstep; const char* cB = (const char*)g.Bt + (size_t)cur.pn * tstep;
    PG8_STAGE(PG8_SB(0, 0), cB, voffB); PG8_STAGE(PG8_SA(0, 0), cA, voffA); PG8_STAGE(PG8_SB(0, 1), cB + hstep, voffB); PG8_STAGE(PG8_SA(0, 1), cA + hstep, voffA);
    if (wr == 1) PG8_BAR;
    PG8_WAIT_V(4); PG8_BAR;
    PG8_STAGE(PG8_SB(1, 0), cB + kstep, voffB); PG8_STAGE(PG8_SA(1, 0), cA + kstep, voffA); PG8_STAGE(PG8_SB(1, 1), cB + hstep + kstep, voffB);
    PG8_WAIT_V(6); PG8_BAR;
    for (;;) {
        const bool has_next = S.next(ui + 1, nxt);
        const char* nA = has_next ? (const char*)g.A + (size_t)nxt.pm * tstep : cA; const char* nB = has_next ? (const char*)g.Bt + (size_t)nxt.pn * tstep : cB;
        for (int t = 0; t < nt; t += 2) {
            const bool last = (t == nt - 2);
            const char* a1 = cA + (size_t)(t + 1) * kstep;
            const char* a2 = last ? nA : cA + (size_t)(t + 2) * kstep; const char* b2 = last ? nB : cB + (size_t)(t + 2) * kstep;
            const char* a3 = a2 + kstep; const char* b3 = b2 + kstep;
            PG8_LDB(B0, 0, 0); PG8_SCHED; PG8_LDA(At, 0, 0); PG8_STAGE(PG8_SA(1, 1), a1 + hstep, voffA);
            PG8_WAIT_L(8); PG8_BAR; PG8_WAIT_L(0); PG8_MMA(0, 0, At, B0); PG8_BAR; PG8_SCHED;
            PG8_LDB(B1, 0, 1); PG8_STAGE(PG8_SB(0, 0), b2, voffB);
            PG8_BAR; PG8_WAIT_L(0); PG8_MMA(0, 1, At, B1); PG8_BAR;
            PG8_LDA(At, 0, 1); PG8_STAGE(PG8_SA(0, 0), a2, voffA);
            PG8_BAR; PG8_WAIT_L(0); PG8_MMA(1, 0, At, B0); PG8_BAR; PG8_SCHED;
            PG8_STAGE(PG8_SB(0, 1), b2 + hstep, voffB);
            PG8_WAIT_V(6); PG8_BAR; PG8_MMA(1, 1, At, B1); PG8_BAR;
            PG8_LDB(B0, 1, 0); PG8_SCHED; PG8_LDA(At, 1, 0); PG8_STAGE(PG8_SA(0, 1), a2 + hstep, voffA);
            PG8_WAIT_L(8); PG8_BAR; PG8_WAIT_L(0); PG8_MMA(0, 0, At, B0); PG8_BAR; PG8_SCHED;
            PG8_LDB(B1, 1, 1); PG8_STAGE(PG8_SB(1, 0), b3, voffB);
            PG8_BAR; PG8_WAIT_L(0); PG8_MMA(0, 1, At, B1); PG8_BAR;
            PG8_LDA(At, 1, 1); PG8_STAGE(PG8_SA(1, 0), a3, voffA);
            PG8_BAR; PG8_WAIT_L(0); PG8_MMA(1, 0, At, B0); PG8_BAR; PG8_SCHED;
            PG8_STAGE(PG8_SB(1, 1), b3 + hstep, voffB);
            PG8_WAIT_V(6); PG8_BAR; PG8_MMA(1, 1, At, B1); PG8_BAR;
        }
        if constexpr (!Epi::AFTER_DRAIN) E(acc, cur, wr, wc, fr, fq);
        if (!has_next) break;
#pragma unroll
        for (int a = 0; a < 2; ++a)
#pragma unroll
            for (int b = 0; b < 2; ++b)
#pragma unroll
                for (int m = 0; m < 4; ++m)
#pragma unroll
                    for (int n = 0; n < 2; ++n) acc[a][b][m][n] = (f32x4){0.f, 0.f, 0.f, 0.f};
        cur = nxt; cA = nA; cB = nB; ++ui;
    }
    PG8_WAIT_V(0);
    if (wr == 0) PG8_BAR;
    PG8_BAR;
    if constexpr (Epi::AFTER_DRAIN) E.fused(acc, cur, wr, wc, fr, fq, lds, wid, lane);
#undef PG8_SA
#undef PG8_SB
#undef PG8_STAGE
#undef PG8_LDA
#undef PG8_LDB
#undef PG8_MMA
#undef PG8_WAIT_V
#undef PG8_WAIT_L
#undef PG8_BAR
#undef PG8_SCHED
}
}

__device__ __forceinline__ void p0_transpose_tile(const float* __restrict__ src, int N, bf16_t* __restrict__ dst, int tile, LAS float* tl) {
    const int tid = otid(); const int ntn = N >> 6; const int nt = tile % ntn, kt = tile / ntn; const int n0 = nt * 64, k0 = kt * 64;
#pragma unroll
    for (int it = 0; it < 2; ++it) { const int row = (tid >> 4) + 32 * it, c4 = (tid & 15) * 4;
        const f32x4 v = *(const f32x4*)(src + (size_t)(k0 + row) * N + n0 + c4);
        tl[row * 65 + c4 + 0] = v[0]; tl[row * 65 + c4 + 1] = v[1]; tl[row * 65 + c4 + 2] = v[2]; tl[row * 65 + c4 + 3] = v[3]; }
    __syncthreads();
    { const int n = tid >> 3, ks = tid & 7; float f[8];
#pragma unroll
      for (int j = 0; j < 8; ++j) f[j] = tl[(ks * 8 + j) * 65 + n];
      u32x4 w; w.x = cvt_pk_bf16(f[0], f[1]); w.y = cvt_pk_bf16(f[2], f[3]); w.z = cvt_pk_bf16(f[4], f[5]); w.w = cvt_pk_bf16(f[6], f[7]);
      *(u32x4*)(dst + (size_t)(n0 + n) * 1024 + k0 + ks * 8) = w; }
    __syncthreads();
}

__device__ void tr_range(const Params& P, LAS unsigned char* lds, int t_begin, int t_end, int start, int stride) {
    LAS float* tl = (LAS float*)lds;
    constexpr int T0 = 2 * (EVEN_IN / 64) * 16, T1 = 2 * 16 * 16, T2 = 2 * (ODD_IN / 64) * 16;
    for (int t = t_begin + start; t < t_end; t += stride) {
        const float* src; bf16_t* dst; int N, tt;
        if (t < T0) { const int per = T0 / 2, p = t / per; tt = t % per; N = EVEN_IN; src = P.w_in_e + (size_t)p * 1024 * EVEN_IN; dst = (bf16_t*)(P.ws + WS_WINE) + (size_t)p * EVEN_IN * 1024; }
        else if (t < T0 + T1) { const int u = t - T0, per = T1 / 2, p = u / per; tt = u % per; N = 1024; src = P.w_out_e + (size_t)p * 1024 * 1024; dst = (bf16_t*)(P.ws + WS_WOUTE) + (size_t)p * 1024 * 1024; }
        else if (t < T0 + T1 + T2) { const int u = t - T0 - T1, per = T2 / 2, p = u / per; tt = u % per; N = ODD_IN; src = P.w_in_o + (size_t)p * 1024 * ODD_IN; dst = (bf16_t*)(P.ws + WS_WINO) + (size_t)p * ODD_IN * 1024; }
        else { const int u = t - T0 - T1 - T2, per = 256, p = u / per; tt = u % per; N = 1024; src = P.w_out_o + (size_t)p * 1024 * 1024; dst = (bf16_t*)(P.ws + WS_WOUTO) + (size_t)p * 1024 * 1024; }
        p0_transpose_tile(src, N, dst, tt, tl);
    }
}

__device__ void p0_phase(const Params& P, LAS unsigned char* lds) {
    const int tid = otid(), bid = blockIdx.x, G = gridDim.x;
    if (bid < 192) {
        LAS float* s = (LAS float*)lds;
        LAS float* red = (LAS float*)(lds + 9 * 1024 * 4);
        for (int i = tid; i < 9 * 1024; i += NTHREADS) { const int ci = i >> 10, k = i & 1023; const float v = ci == 0 ? P.c_ctx[k] : P.c[(ci - 1) * 1024 + k]; s[i] = siluf_(v); }
        __syncthreads();
        const int L = bid / 48, jb = bid % 48; const int kg = tid >> 6, col = tid & 63;
        const float* w = P.w_ada + (size_t)L * 1024 * 3072 + (size_t)(kg * 128) * 3072 + jb * 64 + col;
        float acc[9];
#pragma unroll
        for (int i = 0; i < 9; ++i) acc[i] = 0.f;
        for (int k = 0; k < 128; k += 4) {
            float wv[4];
#pragma unroll
            for (int kk = 0; kk < 4; ++kk) wv[kk] = w[(size_t)(k + kk) * 3072];
#pragma unroll
            for (int i = 0; i < 9; ++i) { const f32x4 sv = *(const LAS f32x4*)(s + i * 1024 + kg * 128 + k); acc[i] += sv[0] * wv[0] + sv[1] * wv[1] + sv[2] * wv[2] + sv[3] * wv[3]; }
        }
#pragma unroll
        for (int i = 0; i < 9; ++i) red[(kg * 9 + i) * 64 + col] = acc[i];
        __syncthreads();
        float* mod = (float*)(P.ws + WS_MOD);
        for (int o = tid; o < 9 * 64; o += NTHREADS) { const int i = o >> 6, cc = o & 63; float a = P.b_ada[L * 3072 + jb * 64 + cc];
#pragma unroll
            for (int q = 0; q < 8; ++q) a += red[(q * 9 + i) * 64 + cc];
            mod[((size_t)L * 9 + i) * 3072 + jb * 64 + cc] = a; }
        __syncthreads();
    }
    if (bid == G - 1 && tid < 16) {
        float* rt = (float*)(P.ws + WS_ROPE);
        double inv = 1.0; for (int j = 0; j < tid; ++j) inv *= 0.5623413251903491;
        const double x = inv, x2 = x * x;
        double sn = x, term = x; for (int n = 1; n < 12; ++n) { term *= -x2 / ((2.0 * n) * (2.0 * n + 1.0)); sn += term; }
        double cs = 1.0; term = 1.0; for (int n = 1; n < 12; ++n) { term *= -x2 / ((2.0 * n - 1.0) * (2.0 * n)); cs += term; }
        double c = 1.0, sv = 0.0;
        for (int pos = 0; pos < 64; ++pos) {
            rt[512 + pos * 16 + tid] = (float)c; rt[1536 + pos * 16 + tid] = (float)sv;
            if (pos < 16) { rt[pos * 16 + tid] = (float)c; rt[256 + pos * 16 + tid] = (float)sv; }
            const double c2 = c * cs - sv * sn, s2 = sv * cs + c * sn; c = c2; sv = s2;
        }
    }
    tr_range(P, lds, 0, 1088, bid, G);
}

__device__ void modulate_phase(const Params& P, int L) {
    const int tid_ = otid(); const int lane = tid_ & 63, gw = ((gridDim.x & 7) == 0 ? ((int)blockIdx.x & 7) * ((int)gridDim.x >> 3) + ((int)blockIdx.x >> 3) : (int)blockIdx.x) * 8 + (tid_ >> 6), nw = gridDim.x * 8;
    const float* mod = (const float*)(P.ws + WS_MOD) + (size_t)L * 9 * 3072;
    bf16_t* h = (bf16_t*)(P.ws + WS_HMIX);
    const float* g = P.norm_g + L * 1024;
    for (int row = gw; row < NTOK; row += nw) {
        const float* xr = (L == 0) ? (row < NPR ? P.x_prompt + (size_t)row * DM : P.x_sample + (size_t)(row - NPR) * DM) : P.out + (size_t)row * DM;
        const int mi = row < NPR ? 0 : 1 + ((row - NPR) >> 10);
        const float* mr = mod + mi * 3072;
        f32x4 v[4], gv[4], sh[4], sc[4]; float ss = 0.f;
#pragma unroll
        for (int i = 0; i < 4; ++i) { const int c = i * 256 + lane * 4; v[i] = *(const f32x4*)(xr + c); gv[i] = *(const f32x4*)(g + c); sh[i] = *(const f32x4*)(mr + c); sc[i] = *(const f32x4*)(mr + 1024 + c); }
#pragma unroll
        for (int i = 0; i < 4; ++i) ss += v[i][0] * v[i][0] + v[i][1] * v[i][1] + v[i][2] * v[i][2] + v[i][3] * v[i][3];
        ss = allred64(ss);
        const float rs = rsqrtf(ss * (1.0f / 1024.0f) + 1e-6f);
#pragma unroll
        for (int i = 0; i < 4; ++i) { const int c = i * 256 + lane * 4;
            float o[4];
#pragma unroll
            for (int j = 0; j < 4; ++j) o[j] = v[i][j] * rs * gv[i][j] * (1.0f + sc[i][j]) + sh[i][j];
            u32x2 w; w.x = cvt_pk_bf16(o[0], o[1]); w.y = cvt_pk_bf16(o[2], o[3]); *(u32x2*)(h + (size_t)row * DM + c) = w; }
    }
}
__device__ void final_phase(const Params& P) {
    const int tid_ = otid(); const int lane = tid_ & 63, gw = ((gridDim.x & 7) == 0 ? ((int)blockIdx.x & 7) * ((int)gridDim.x >> 3) + ((int)blockIdx.x >> 3) : (int)blockIdx.x) * 8 + (tid_ >> 6), nw = gridDim.x * 8;
    f32x4 gv[4];
#pragma unroll
    for (int i = 0; i < 4; ++i) gv[i] = *(const f32x4*)(P.final_g + i * 256 + lane * 4);
    for (int row = gw; row < NTOK; row += nw) {
        float* xr = P.out + (size_t)row * DM;
        f32x4 v[4]; float ss = 0.f;
#pragma unroll
        for (int i = 0; i < 4; ++i) { v[i] = *(const f32x4*)(xr + i * 256 + lane * 4); ss += v[i][0] * v[i][0] + v[i][1] * v[i][1] + v[i][2] * v[i][2] + v[i][3] * v[i][3]; }
        ss = allred64(ss);
        const float rs = rsqrtf(ss * (1.0f / 1024.0f) + 1e-6f);
#pragma unroll
        for (int i = 0; i < 4; ++i) *(f32x4*)(xr + i * 256 + lane * 4) = v[i] * rs * gv[i];
    }
}

constexpr int TP = 68;
constexpr int TA = 16 * TP * 4;
constexpr int SC_R = 0, SC_V = TA, SC_W = 2 * TA, SC_K = 3 * TA, SC_KK = 4 * TA, SC_B = 5 * TA, SC_FK = 6 * TA, SC_TL = 7 * TA, SC_LA = SC_TL + 2304, SC_KDT = SC_LA + 2304, SC_BT = SC_KDT + 2560, SC_GC = SC_BT + 2560, SC_KTB = SC_GC + 256, SC_RTB = SC_KTB + 2304, SC_PB = SC_RTB + 2304;
constexpr int SC_Y = 2 * SC_PB, SC_BSP = SC_Y + 4096, SC_AKT = SC_BSP + 256, SC_TINV = SC_AKT + 1280, SC_GKR = SC_TINV + 1280, SC_GBR = SC_GKR + 1280, SC_ABTT = SC_GBR + 1280, SC_NO = SC_ABTT + 1280, SC_END = SC_NO + 1280;
static_assert(SC_END <= 131072, "scan LDS");

__device__ __forceinline__ f32x4 shift4(u32x2 pv, u32x2 cv, u32x2 nv, bool hp, bool hn, f32x4 mu) {
    f32x4 f = {bflo(cv.x), bfhi(cv.x), bflo(cv.y), bfhi(cv.y)};
    f32x4 a = {0.f, 0.f, 0.f, 0.f};
    if (hp) a += (f32x4){bflo(pv.x), bfhi(pv.x), bflo(pv.y), bfhi(pv.y)};
    if (hn) a += (f32x4){bflo(nv.x), bfhi(nv.x), bflo(nv.y), bfhi(nv.y)};
    return f + mu * (0.5f * a - f);
}
#define MF32(a, b, c) __builtin_amdgcn_mfma_f32_16x16x4f32((a), (b), (c), 0, 0, 0)

#define LBAR() do { asm volatile("s_waitcnt lgkmcnt(0)" ::: "memory"); __builtin_amdgcn_s_barrier(); asm volatile("" ::: "memory"); } while (0)
template <bool SMP> __device__ void scan_chain(const Params& P, LAS unsigned char* lds, int p, int b, int h, int d) {
    const int tid = otid(), wave = __builtin_amdgcn_readfirstlane(tid >> 6), lane = tid & 63, l15 = lane & 15, q4 = lane >> 4;
    const bool isA = wave >= 4; const int ptid = tid & 255, pw = wave & 3;
    const int Lseq = SMP ? 1024 : 256; const int rowbase = SMP ? NPR + b * 1024 : b * 256;
    const int nchunks = Lseq >> 4;
    const bf16_t* proj = (const bf16_t*)(P.ws + WS_PROJ);
    float* bsg = (float*)(P.ws + WS_BS);
    bf16_t* yg = (bf16_t*)(P.ws + WS_Y);
    const int tt1 = ptid >> 4, q1 = ptid & 15;
    const int tr1 = d ? 15 - tt1 : tt1;
    if (isA) {
        bf16x8 bw[2], ba[2];
        { const int c = h * 64 + pw * 16 + l15; const float* w2 = P.lora_w2 + ((size_t)(p * 2 + d) * 64) * 512 + c; const float* a2 = P.lora_a2 + ((size_t)(p * 2 + d) * 64) * 512 + c;
#pragma unroll
          for (int ks = 0; ks < 2; ++ks) { float fw[8], fa[8];
#pragma unroll
              for (int e = 0; e < 8; ++e) { const int r = ks * 32 + q4 * 8 + e; fw[e] = w2[(size_t)r * 512]; fa[e] = a2[(size_t)r * 512]; }
              u32x4 uw, ua; uw.x = cvt_pk_bf16(fw[0], fw[1]); uw.y = cvt_pk_bf16(fw[2], fw[3]); uw.z = cvt_pk_bf16(fw[4], fw[5]); uw.w = cvt_pk_bf16(fw[6], fw[7]);
              ua.x = cvt_pk_bf16(fa[0], fa[1]); ua.y = cvt_pk_bf16(fa[2], fa[3]); ua.z = cvt_pk_bf16(fa[4], fa[5]); ua.w = cvt_pk_bf16(fa[6], fa[7]);
              bw[ks] = __builtin_bit_cast(bf16x8, uw); ba[ks] = __builtin_bit_cast(bf16x8, ua); } }
        const int c2 = pw * 16 + l15, hc2 = h * 64 + c2;
        const float w0c = P.w0[(p * 2 + d) * 512 + hc2], a0c = P.a0[(p * 2 + d) * 512 + hc2], kac = P.k_a[p * 512 + hc2], rkc = P.r_k[p * 512 + hc2];
        const int co_r = h * 64 + q1 * 4, co_k = 512 + co_r, co_v = 1024 + co_r, co_lw = 1536 + d * 64 + q1 * 4, co_la = 1664 + d * 64 + q1 * 4;
        const f32x4 mu_r = *(const f32x4*)(P.mu_shift + p * 1792 + co_r), mu_k = *(const f32x4*)(P.mu_shift + p * 1792 + co_k), mu_v = *(const f32x4*)(P.mu_shift + p * 1792 + co_v),
                    mu_lw = *(const f32x4*)(P.mu_shift + p * 1792 + co_lw), mu_la = *(const f32x4*)(P.mu_shift + p * 1792 + co_la), kk4 = *(const f32x4*)(P.k_k + p * 512 + h * 64 + q1 * 4);
        u32x2 g_r[2][3], g_k[2][3], g_v[2][3], g_lw[2][3], g_la[2][3];
#define SC_PRELOAD(ci_, S_) do { const int t0_ = d ? Lseq - 16 * ((ci_) + 1) : 16 * (ci_); const int t_ = t0_ + tt1; \
        const bf16_t* rc_ = proj + (size_t)(rowbase + t_) * EVEN_IN; const bf16_t* rp_ = rc_ - EVEN_IN; const bf16_t* rn_ = rc_ + EVEN_IN;     \
        g_r[S_][0] = *(const u32x2*)(rp_ + co_r); g_r[S_][1] = *(const u32x2*)(rc_ + co_r); g_r[S_][2] = *(const u32x2*)(rn_ + co_r); \
        g_k[S_][0] = *(const u32x2*)(rp_ + co_k); g_k[S_][1] = *(const u32x2*)(rc_ + co_k); g_k[S_][2] = *(const u32x2*)(rn_ + co_k); \
        g_v[S_][0] = *(const u32x2*)(rp_ + co_v); g_v[S_][1] = *(const u32x2*)(rc_ + co_v); g_v[S_][2] = *(const u32x2*)(rn_ + co_v); \
        g_lw[S_][0] = *(const u32x2*)(rp_ + co_lw); g_lw[S_][1] = *(const u32x2*)(rc_ + co_lw); g_lw[S_][2] = *(const u32x2*)(rn_ + co_lw); \
        g_la[S_][0] = *(const u32x2*)(rp_ + co_la); g_la[S_][1] = *(const u32x2*)(rc_ + co_la); g_la[S_][2] = *(const u32x2*)(rn_ + co_la); } while (0)
        SC_PRELOAD(0, 0); SC_PRELOAD(1, 1);
        for (int cc2 = 0; cc2 < nchunks; cc2 += 2) {
#pragma unroll
          for (int par = 0; par < 2; ++par) {
            const int cc = cc2 + par;
            constexpr bool act = true;
            LAS unsigned char* cl = lds + (cc & 1) * SC_PB;
            const int t0 = d ? Lseq - 16 * (cc + 1) : 16 * cc;
            if (act) {
                const int t = t0 + tt1; const bool hp = t > 0, hn = t < Lseq - 1;
                const f32x4 fr = shift4(g_r[par][0], g_r[par][1], g_r[par][2], hp, hn, mu_r);
                const f32x4 fk = shift4(g_k[par][0], g_k[par][1], g_k[par][2], hp, hn, mu_k);
                const f32x4 fv = shift4(g_v[par][0], g_v[par][1], g_v[par][2], hp, hn, mu_v);
                const f32x4 flw = shift4(g_lw[par][0], g_lw[par][1], g_lw[par][2], hp, hn, mu_lw);
                const f32x4 fla = shift4(g_la[par][0], g_la[par][1], g_la[par][2], hp, hn, mu_la);
                *(LAS f32x4*)(cl + SC_R + (tr1 * TP + q1 * 4) * 4) = fr;
                *(LAS f32x4*)(cl + SC_V + (tr1 * TP + q1 * 4) * 4) = fv;
                *(LAS f32x4*)(cl + SC_FK + (tr1 * TP + q1 * 4) * 4) = fk;
                f32x4 kr = fk * kk4; float ss = kr[0] * kr[0] + kr[1] * kr[1] + kr[2] * kr[2] + kr[3] * kr[3];
                ss = allred16(ss);
                const float inv = __builtin_amdgcn_rsqf(fmaxf(ss, 1e-24f));
                *(LAS f32x4*)(cl + SC_KK + (tr1 * TP + q1 * 4) * 4) = kr * inv;
                u32x2 tw; tw.x = cvt_pk_bf16(tanhf_(flw[0]), tanhf_(flw[1])); tw.y = cvt_pk_bf16(tanhf_(flw[2]), tanhf_(flw[3]));
                *(LAS u32x2*)(cl + SC_TL + (tr1 * 72 + q1 * 4) * 2) = tw;
                u32x2 aw; aw.x = cvt_pk_bf16(fla[0], fla[1]); aw.y = cvt_pk_bf16(fla[2], fla[3]);
                *(LAS u32x2*)(cl + SC_LA + (tr1 * 72 + q1 * 4) * 2) = aw;
                { const int cn = cc + 2 < nchunks ? cc + 2 : nchunks - 1; SC_PRELOAD(cn, par); }
            }
            LBAR();
            if (act) {
                f32x4 wl = {0.f, 0.f, 0.f, 0.f}, al = {0.f, 0.f, 0.f, 0.f};
#pragma unroll
                for (int ks = 0; ks < 2; ++ks) {
                    const bf16x8 atl = *(const LAS bf16x8*)(cl + SC_TL + (l15 * 72 + ks * 32 + q4 * 8) * 2);
                    const bf16x8 ala = *(const LAS bf16x8*)(cl + SC_LA + (l15 * 72 + ks * 32 + q4 * 8) * 2);
                    wl = __builtin_amdgcn_mfma_f32_16x16x32_bf16(atl, bw[ks], wl, 0, 0, 0);
                    al = __builtin_amdgcn_mfma_f32_16x16x32_bf16(ala, ba[ks], al, 0, 0, 0);
                }
                float bsp[4];
#pragma unroll
                for (int j = 0; j < 4; ++j) {
                    const int t = q4 * 4 + j;
                    const float w = __expf(-0.6065306597f * sigmoidf_(w0c + wl[j]));
                    const float a = sigmoidf_(a0c + al[j]);
                    const float k = *(const LAS float*)(cl + SC_FK + (t * TP + c2) * 4);
                    const float kd = k * (1.0f + (a - 1.0f) * kac);
                    const float kkv = *(const LAS float*)(cl + SC_KK + (t * TP + c2) * 4);
                    *(LAS float*)(cl + SC_W + (t * TP + c2) * 4) = w;
                    *(LAS float*)(cl + SC_K + (t * TP + c2) * 4) = kd;
                    *(LAS float*)(cl + SC_B + (t * TP + c2) * 4) = kkv * a;
                    const float r = *(const LAS float*)(cl + SC_R + (t * TP + c2) * 4);
                    bsp[j] = allred16(r * kd * rkc);
                }
                if (l15 == 0) {
#pragma unroll
                    for (int j = 0; j < 4; ++j) *(LAS float*)(lds + SC_BSP + (pw * 16 + q4 * 4 + j) * 4) = bsp[j];
                }
            }
            LBAR();
            if (act) {
                const int c = lane;
                float g[16];
#pragma unroll
                for (int t = 0; t < 16; ++t) g[t] = *(const LAS float*)(cl + SC_W + (t * TP + c) * 4);
                float wst[16];
#pragma unroll
                for (int t = 0; t < 16; ++t) wst[t] = g[t];
#pragma unroll
                for (int t = 1; t < 16; ++t) g[t] *= g[t - 1];
                if (pw == 0) {
                    float kk[16];
#pragma unroll
                    for (int t = 0; t < 16; ++t) kk[t] = *(const LAS float*)(cl + SC_KK + (t * TP + c) * 4);
#pragma unroll
                    for (int t = 1; t < 16; ++t) { kk[t] *= g[t - 1]; *(LAS float*)(cl + SC_KK + (t * TP + c) * 4) = kk[t]; }
#pragma unroll
                    for (int t = 0; t < 16; t += 2) { const unsigned w = cvt_pk_bf16(kk[t], kk[t + 1]); *(LAS bf16_t*)(cl + SC_KTB + (t * 72 + c) * 2) = (bf16_t)(w & 0xffff); *(LAS bf16_t*)(cl + SC_KTB + ((t + 1) * 72 + c) * 2) = (bf16_t)(w >> 16); }
                    *(LAS float*)(cl + SC_GC + c * 4) = g[15];
                } else if (pw == 1) {
                    float rr[16];
#pragma unroll
                    for (int t = 0; t < 16; ++t) rr[t] = *(const LAS float*)(cl + SC_R + (t * TP + c) * 4);
#pragma unroll
                    for (int t = 0; t < 16; ++t) { rr[t] *= g[t]; *(LAS float*)(cl + SC_R + (t * TP + c) * 4) = rr[t]; }
#pragma unroll
                    for (int t = 0; t < 16; t += 2) { const unsigned w = cvt_pk_bf16(rr[t], rr[t + 1]); *(LAS bf16_t*)(cl + SC_RTB + (t * 72 + c) * 2) = (bf16_t)(w & 0xffff); *(LAS bf16_t*)(cl + SC_RTB + ((t + 1) * 72 + c) * 2) = (bf16_t)(w >> 16); }
                } else if (pw == 2) {
                    float kd[16];
#pragma unroll
                    for (int t = 0; t < 16; ++t) kd[t] = *(const LAS float*)(cl + SC_K + (t * TP + c) * 4);
                    { float ig = __builtin_amdgcn_rcpf(g[15]);
#pragma unroll
                      for (int t = 15; t >= 0; --t) { kd[t] *= ig; ig *= wst[t]; *(LAS float*)(cl + SC_K + (t * TP + c) * 4) = kd[t]; } }
#pragma unroll
                    for (int t8 = 0; t8 < 2; ++t8) { u32x4 w; w.x = cvt_pk_bf16(kd[8 * t8], kd[8 * t8 + 1]); w.y = cvt_pk_bf16(kd[8 * t8 + 2], kd[8 * t8 + 3]); w.z = cvt_pk_bf16(kd[8 * t8 + 4], kd[8 * t8 + 5]); w.w = cvt_pk_bf16(kd[8 * t8 + 6], kd[8 * t8 + 7]);
                        *(LAS u32x2*)(cl + SC_KDT + c * 40 + t8 * 16) = (u32x2){w.x, w.y}; *(LAS u32x2*)(cl + SC_KDT + c * 40 + t8 * 16 + 8) = (u32x2){w.z, w.w}; }
                } else {
                    float bt[16];
#pragma unroll
                    for (int t = 0; t < 16; ++t) bt[t] = *(const LAS float*)(cl + SC_B + (t * TP + c) * 4);
                    { float ig = __builtin_amdgcn_rcpf(g[15]);
#pragma unroll
                      for (int t = 15; t >= 0; --t) { bt[t] *= ig; ig *= wst[t]; *(LAS float*)(cl + SC_B + (t * TP + c) * 4) = bt[t]; } }
#pragma unroll
                    for (int t8 = 0; t8 < 2; ++t8) { u32x4 w; w.x = cvt_pk_bf16(-bt[8 * t8], -bt[8 * t8 + 1]); w.y = cvt_pk_bf16(-bt[8 * t8 + 2], -bt[8 * t8 + 3]); w.z = cvt_pk_bf16(-bt[8 * t8 + 4], -bt[8 * t8 + 5]); w.w = cvt_pk_bf16(-bt[8 * t8 + 6], -bt[8 * t8 + 7]);
                        *(LAS u32x2*)(cl + SC_BT + c * 40 + t8 * 16) = (u32x2){w.x, w.y}; *(LAS u32x2*)(cl + SC_BT + c * 40 + t8 * 16 + 8) = (u32x2){w.z, w.w}; }
                }
            }
            LBAR();
          }
        }
        LBAR(); LBAR(); LBAR();
#undef SC_PRELOAD
    } else {
        const int vt = pw;
        f32x4 St[4];
#pragma unroll
        for (int kt = 0; kt < 4; ++kt) St[kt] = (f32x4){0.f, 0.f, 0.f, 0.f};
        if (SMP) {
            const float* s0 = P.state_rwkv + ((((size_t)b * 2 + p) * 2 + d) * 8 + h) * 4096 + (16 * vt + l15) * 64 + 4 * q4;
#pragma unroll
            for (int kt = 0; kt < 4; ++kt) St[kt] = *(const f32x4*)(s0 + 16 * kt);
        }
        for (int cc = 0; cc <= nchunks; ++cc) {
            const bool act = cc > 0; const int ci = cc - 1;
            const LAS unsigned char* cl = lds + (ci & 1) * SC_PB;
            const int t0 = d ? Lseq - 16 * (ci + 1) : 16 * ci;
            if (act) {
                const LAS unsigned char* xa = cl + (pw < 2 ? SC_KK : SC_R) + (l15 * TP + 4 * q4) * 4;
                const LAS unsigned char* zb = cl + ((pw & 1) ? SC_B : SC_K) + (l15 * TP + 4 * q4) * 4;
                f32x4 ga4[4], gb4_[4];
#pragma unroll
                for (int kt = 0; kt < 4; ++kt) { ga4[kt] = *(const LAS f32x4*)(xa + kt * 64); gb4_[kt] = *(const LAS f32x4*)(zb + kt * 64); }
                f32x4 acc = {0.f, 0.f, 0.f, 0.f};
                if (pw == 1) {
                    f32x4 ac[4];
#pragma unroll
                    for (int kt = 0; kt < 4; ++kt) ac[kt] = (f32x4){0.f, 0.f, 0.f, 0.f};
#pragma unroll
                    for (int j = 0; j < 4; ++j)
#pragma unroll
                        for (int kt = 0; kt < 4; ++kt) ac[kt] = MF32(ga4[kt][j], gb4_[kt][j], ac[kt]);
                    acc = (ac[0] + ac[1]) + (ac[2] + ac[3]);
                } else {
#pragma unroll
                    for (int ks = 0; ks < 2; ++ks) { const u32x4 ua = {cvt_pk_bf16(ga4[2 * ks][0], ga4[2 * ks][1]), cvt_pk_bf16(ga4[2 * ks][2], ga4[2 * ks][3]), cvt_pk_bf16(ga4[2 * ks + 1][0], ga4[2 * ks + 1][1]), cvt_pk_bf16(ga4[2 * ks + 1][2], ga4[2 * ks + 1][3])};
                        const u32x4 ub = {cvt_pk_bf16(gb4_[2 * ks][0], gb4_[2 * ks][1]), cvt_pk_bf16(gb4_[2 * ks][2], gb4_[2 * ks][3]), cvt_pk_bf16(gb4_[2 * ks + 1][0], gb4_[2 * ks + 1][1]), cvt_pk_bf16(gb4_[2 * ks + 1][2], gb4_[2 * ks + 1][3])};
                        acc = __builtin_amdgcn_mfma_f32_16x16x32_bf16(__builtin_bit_cast(bf16x8, ua), __builtin_bit_cast(bf16x8, ub), acc, 0, 0, 0); }
                }
                if (pw != 1) {
                    LAS unsigned char* mo = lds + (pw == 0 ? SC_AKT : pw == 2 ? SC_GKR : SC_GBR);
#pragma unroll
                    for (int j = 0; j < 4; ++j) { const int t = 4 * q4 + j; const bool keep = (pw == 0) ? (l15 < t) : (l15 <= t); float v = keep ? acc[j] : 0.f; if (pw == 3) v = -v;
                        *(LAS float*)(mo + (t * 20 + l15) * 4) = v; }
                } else {
#pragma unroll
                    for (int j = 0; j < 4; ++j) { const int t = 4 * q4 + j; const float v = (l15 < t) ? acc[j] : 0.f; const bool same = (l15 >> 2) == q4;
                        *(LAS float*)(lds + SC_ABTT + (t * 20 + l15) * 4) = same ? v : 0.f; *(LAS float*)(lds + SC_NO + (t * 20 + l15) * 4) = same ? 0.f : v; }
                    asm volatile("s_waitcnt lgkmcnt(0)" ::: "memory");
                    float r0_ = (4 * q4 + 0 == l15) ? 1.f : 0.f, r1_ = (4 * q4 + 1 == l15) ? 1.f : 0.f, r2_ = (4 * q4 + 2 == l15) ? 1.f : 0.f, r3_ = (4 * q4 + 3 == l15) ? 1.f : 0.f, u0_, u1_, u2_, u3_;
                    const f32x4 dg1 = *(const LAS f32x4*)(lds + SC_ABTT + ((4 * q4 + 1) * 20 + 4 * q4) * 4), dg2 = *(const LAS f32x4*)(lds + SC_ABTT + ((4 * q4 + 2) * 20 + 4 * q4) * 4),
                                dg3 = *(const LAS f32x4*)(lds + SC_ABTT + ((4 * q4 + 3) * 20 + 4 * q4) * 4);
                    f32x4 cN[3][4];
#pragma unroll
                    for (int bb = 0; bb < 3; ++bb)
#pragma unroll
                        for (int j = 0; j < 4; ++j) cN[bb][j] = *(const LAS f32x4*)(lds + SC_NO + ((4 * q4 + j) * 20 + 4 * bb) * 4);
#define DIAGSOLVE() do { u0_ = r0_; u1_ = r1_ - dg1[0] * u0_; u2_ = r2_ - dg2[0] * u0_ - dg2[1] * u1_; u3_ = r3_ - dg3[0] * u0_ - dg3[1] * u1_ - dg3[2] * u2_; } while (0)
#pragma unroll
                    for (int bb = 0; bb < 3; ++bb) {
                        DIAGSOLVE();
                        const int src = l15 + 16 * bb;
                        const float b0 = __shfl(u0_, src), b1 = __shfl(u1_, src), b2 = __shfl(u2_, src), b3 = __shfl(u3_, src);
                        r0_ -= cN[bb][0][0] * b0 + cN[bb][0][1] * b1 + cN[bb][0][2] * b2 + cN[bb][0][3] * b3;
                        r1_ -= cN[bb][1][0] * b0 + cN[bb][1][1] * b1 + cN[bb][1][2] * b2 + cN[bb][1][3] * b3;
                        r2_ -= cN[bb][2][0] * b0 + cN[bb][2][1] * b1 + cN[bb][2][2] * b2 + cN[bb][2][3] * b3;
                        r3_ -= cN[bb][3][0] * b0 + cN[bb][3][1] * b1 + cN[bb][3][2] * b2 + cN[bb][3][3] * b3;
                    }
                    DIAGSOLVE();
#undef DIAGSOLVE
                    *(LAS float*)(lds + SC_TINV + ((4 * q4 + 0) * 20 + l15) * 4) = u0_; *(LAS float*)(lds + SC_TINV + ((4 * q4 + 1) * 20 + l15) * 4) = u1_;
                    *(LAS float*)(lds + SC_TINV + ((4 * q4 + 2) * 20 + l15) * 4) = u2_; *(LAS float*)(lds + SC_TINV + ((4 * q4 + 3) * 20 + l15) * 4) = u3_;
                }
            }
            LBAR();
            if (act) {
#define PK4(v) cvt_pk_bf16((v)[0], (v)[1]), cvt_pk_bf16((v)[2], (v)[3])
                f32x4 vB;
#pragma unroll
                for (int j = 0; j < 4; ++j) vB[j] = *(const LAS float*)(cl + SC_V + ((4 * q4 + j) * TP + 16 * vt + l15) * 4);
                bf16x8 bS[2];
#pragma unroll
                for (int ks = 0; ks < 2; ++ks) { const u32x4 w = {PK4(St[2 * ks]), PK4(St[2 * ks + 1])}; bS[ks] = __builtin_bit_cast(bf16x8, w); }
                f32x4 rhs = {0.f, 0.f, 0.f, 0.f}, yv = {0.f, 0.f, 0.f, 0.f};
#pragma unroll
                for (int ks = 0; ks < 2; ++ks) {
                    const u32x2 k0 = *(const LAS u32x2*)(cl + SC_KTB + (l15 * 72 + 32 * ks + 4 * q4) * 2), k1 = *(const LAS u32x2*)(cl + SC_KTB + (l15 * 72 + 32 * ks + 16 + 4 * q4) * 2);
                    const u32x2 r0 = *(const LAS u32x2*)(cl + SC_RTB + (l15 * 72 + 32 * ks + 4 * q4) * 2), r1 = *(const LAS u32x2*)(cl + SC_RTB + (l15 * 72 + 32 * ks + 16 + 4 * q4) * 2);
                    const u32x4 ak = {k0.x, k0.y, k1.x, k1.y}, ar = {r0.x, r0.y, r1.x, r1.y};
                    rhs = __builtin_amdgcn_mfma_f32_16x16x32_bf16(__builtin_bit_cast(bf16x8, ak), bS[ks], rhs, 0, 0, 0);
                    yv = __builtin_amdgcn_mfma_f32_16x16x32_bf16(__builtin_bit_cast(bf16x8, ar), bS[ks], yv, 0, 0, 0);
                }
                const f32x4 a4 = *(const LAS f32x4*)(lds + SC_AKT + (l15 * 20 + 4 * q4) * 4), gk4 = *(const LAS f32x4*)(lds + SC_GKR + (l15 * 20 + 4 * q4) * 4), gb4 = *(const LAS f32x4*)(lds + SC_GBR + (l15 * 20 + 4 * q4) * 4);
                { const u32x4 aa = {PK4(a4), 0u, 0u}, bv = {PK4(vB), 0u, 0u};
                  rhs = __builtin_amdgcn_mfma_f32_16x16x32_bf16(__builtin_bit_cast(bf16x8, aa), __builtin_bit_cast(bf16x8, bv), rhs, 0, 0, 0); }
                f32x4 u = {0.f, 0.f, 0.f, 0.f};
                { const f32x4 t4 = *(const LAS f32x4*)(lds + SC_TINV + (l15 * 20 + 4 * q4) * 4);
#pragma unroll
                  for (int j = 0; j < 4; ++j) u = MF32(t4[j], rhs[j], u); }
                const u32x4 bvu_ = {PK4(vB), PK4(u)}; const bf16x8 bVU = __builtin_bit_cast(bf16x8, bvu_);
                { const u32x4 ag = {PK4(gk4), PK4(gb4)};
                  yv = __builtin_amdgcn_mfma_f32_16x16x32_bf16(__builtin_bit_cast(bf16x8, ag), bVU, yv, 0, 0, 0); }
#pragma unroll
                for (int j = 0; j < 4; ++j) *(LAS float*)(lds + SC_Y + ((4 * q4 + j) * 64 + 16 * vt + l15) * 4) = yv[j];
#pragma unroll
                for (int kt = 0; kt < 4; ++kt) { const u32x2 kd4 = *(const LAS u32x2*)(cl + SC_KDT + (16 * kt + l15) * 40 + 8 * q4), bt4 = *(const LAS u32x2*)(cl + SC_BT + (16 * kt + l15) * 40 + 8 * q4);
                    const u32x4 as_ = {kd4.x, kd4.y, bt4.x, bt4.y};
                    St[kt] = __builtin_amdgcn_mfma_f32_16x16x32_bf16(__builtin_bit_cast(bf16x8, as_), bVU, St[kt], 0, 0, 0);
                    const f32x4 gc = *(const LAS f32x4*)(cl + SC_GC + (16 * kt + 4 * q4) * 4);
                    St[kt] = St[kt] * gc; }
#undef PK4
            }
            LBAR();
            if (cc < nchunks && tid < 16) {
                const int t0c = d ? Lseq - 16 * (cc + 1) : 16 * cc;
                float a = 0.f;
#pragma unroll
                for (int q = 0; q < 4; ++q) a += *(const LAS float*)(lds + SC_BSP + (q * 16 + tid) * 4);
                bsg[((size_t)d * NTOK + rowbase + t0c + (d ? 15 - tid : tid)) * 8 + h] = 0.5f * a;
            }
            if (act) {
                const f32x4 yv = *(const LAS f32x4*)(lds + SC_Y + (tr1 * 64 + q1 * 4) * 4);
                u32x2 w; w.x = cvt_pk_bf16(yv[0], yv[1]); w.y = cvt_pk_bf16(yv[2], yv[3]);
                *(u32x2*)(yg + ((size_t)d * NTOK + rowbase + t0 + tt1) * 512 + h * 64 + q1 * 4) = w;
            }
            LBAR();
        }
        if (!SMP) {
            float* so = P.out + OUT_STATE + ((((size_t)b * 2 + p) * 2 + d) * 8 + h) * 4096 + (16 * vt + l15) * 64 + 4 * q4;
#pragma unroll
            for (int kt = 0; kt < 4; ++kt) *(f32x4*)(so + 16 * kt) = St[kt];
        }
    }
    __syncthreads();
}

__device__ void scan_phase(const Params& P, LAS unsigned char* lds, int p) {
    const int bid = blockIdx.x;
    if (bid < 128) { scan_chain<true>(P, lds, p, bid >> 4, (bid >> 1) & 7, bid & 1); }
    else { for (int j = 0; j < 4; ++j) { const int idx = (bid - 128) + 128 * j; scan_chain<false>(P, lds, p, idx >> 4, (idx >> 1) & 7, idx & 1); } }
}

__device__ __forceinline__ void unpack8(u32x4 v, float (&f)[8]) { f[0] = bflo(v.x); f[1] = bfhi(v.x); f[2] = bflo(v.y); f[3] = bfhi(v.y); f[4] = bflo(v.z); f[5] = bfhi(v.z); f[6] = bflo(v.w); f[7] = bfhi(v.w); }
__device__ __forceinline__ u32x4 pack8(const float (&f)[8]) { u32x4 w; w.x = cvt_pk_bf16(f[0], f[1]); w.y = cvt_pk_bf16(f[2], f[3]); w.z = cvt_pk_bf16(f[4], f[5]); w.w = cvt_pk_bf16(f[6], f[7]); return w; }
__device__ void even_post_phase(const Params& P, int p) {
    const int tid_ = otid(); const int lane = tid_ & 63, gw = ((gridDim.x & 7) == 0 ? ((int)blockIdx.x & 7) * ((int)gridDim.x >> 3) + ((int)blockIdx.x >> 3) : (int)blockIdx.x) * 8 + (tid_ >> 6), nw = gridDim.x * 8;
    const bf16_t* proj = (const bf16_t*)(P.ws + WS_PROJ); const bf16_t* yg = (const bf16_t*)(P.ws + WS_Y); const float* bsg = (const float*)(P.ws + WS_BS);
    bf16_t* mix = (bf16_t*)(P.ws + WS_HMIX);
    const int c = lane * 8, h = lane >> 3;
    float lg[8], lb[8], muv[8], cw0[8], cw1[8], cw2[8], cb[8];
#pragma unroll
    for (int j = 0; j < 8; ++j) { lg[j] = P.lnx_g[p * 512 + c + j]; lb[j] = P.lnx_b[p * 512 + c + j]; muv[j] = P.mu_shift[p * 1792 + 1024 + c + j];
        cw0[j] = P.conv_w[(p * 3 + 0) * 512 + c + j]; cw1[j] = P.conv_w[(p * 3 + 1) * 512 + c + j]; cw2[j] = P.conv_w[(p * 3 + 2) * 512 + c + j]; cb[j] = P.conv_b[p * 512 + c + j]; }
    for (int row = gw; row < NTOK; row += nw) {
        const bool smp = row >= NPR; const int t = smp ? (row - NPR) & 1023 : row & 255; const int Lseq = smp ? 1024 : 256;
        const bool hp = t > 0, hn = t < Lseq - 1;
        const bf16_t* rc = proj + (size_t)row * EVEN_IN; const bf16_t* rp = hp ? rc - EVEN_IN : rc; const bf16_t* rn = hn ? rc + EVEN_IN : rc;
        const u32x4 r_yf = *(const u32x4*)(yg + (size_t)row * 512 + c), r_yb = *(const u32x4*)(yg + ((size_t)NTOK + row) * 512 + c);
        const u32x4 r_vc = *(const u32x4*)(rc + 1024 + c), r_vp = *(const u32x4*)(rp + 1024 + c), r_vn = *(const u32x4*)(rn + 1024 + c), r_ga = *(const u32x4*)(rc + 1792 + c);
        const u32x4 r_cgc = *(const u32x4*)(rc + 2816 + c), r_xc = *(const u32x4*)(rc + 3328 + c), r_cgp = *(const u32x4*)(rp + 2816 + c), r_xp = *(const u32x4*)(rp + 3328 + c);
        const u32x4 r_cgn = *(const u32x4*)(rn + 2816 + c), r_xn = *(const u32x4*)(rn + 3328 + c), r_bg = *(const u32x4*)(rc + 2304 + c), r_gb = *(const u32x4*)(rc + 3840 + c);
        const float bonus = bsg[(size_t)row * 8 + h] + bsg[((size_t)NTOK + row) * 8 + h];
        float yf[8], yb[8], y[8];
        unpack8(r_yf, yf); unpack8(r_yb, yb);
        float s = 0.f;
#pragma unroll
        for (int j = 0; j < 8; ++j) { y[j] = yf[j] + yb[j]; s += y[j]; }
        const float mean = allred8(s) * (1.0f / 64.0f);
        float q = 0.f;
#pragma unroll
        for (int j = 0; j < 8; ++j) { y[j] -= mean; q += y[j] * y[j]; }
        const float rstd = rsqrtf(allred8(q) * (1.0f / 64.0f) + 64e-5f);
        float vc[8], vp[8], vn[8], ga[8], o[8], o2[8];
        unpack8(r_vc, vc); unpack8(r_vp, vp); unpack8(r_vn, vn); unpack8(r_ga, ga);
#pragma unroll
        for (int j = 0; j < 8; ++j) { const float av = (hp ? vp[j] : 0.f) + (hn ? vn[j] : 0.f); const float fv = vc[j] + muv[j] * (0.5f * av - vc[j]);
            o[j] = (y[j] * rstd * lg[j] + lb[j] + bonus * fv) * siluf_(ga[j]); }
        float cgc[8], xc[8], cgp[8], xp_[8], cgn[8], xn[8], bg[8], gb[8];
        unpack8(r_cgc, cgc); unpack8(r_xc, xc); unpack8(r_cgp, cgp); unpack8(r_xp, xp_); unpack8(r_cgn, cgn); unpack8(r_xn, xn); unpack8(r_bg, bg); unpack8(r_gb, gb);
#pragma unroll
        for (int j = 0; j < 8; ++j) { const float up = hp ? cgp[j] * xp_[j] : 0.f, un = hn ? cgn[j] * xn[j] : 0.f, uc = cgc[j] * xc[j];
            const float cv = up * cw0[j] + uc * cw1[j] + un * cw2[j] + cb[j]; o2[j] = bg[j] * cv * siluf_(gb[j]); }
        *(u32x4*)(mix + (size_t)row * DM + c) = pack8(o);
        *(u32x4*)(mix + (size_t)row * DM + 512 + c) = pack8(o2);
    }
}

__device__ void qknorm_phase(const Params& P, int p) {
    const int tid_ = otid(); const int lane = tid_ & 63, gw = ((gridDim.x & 7) == 0 ? ((int)blockIdx.x & 7) * ((int)gridDim.x >> 3) + ((int)blockIdx.x >> 3) : (int)blockIdx.x) * 8 + (tid_ >> 6), nw = gridDim.x * 8;
    bf16_t* proj = (bf16_t*)(P.ws + WS_PROJ); const float* rt = (const float*)(P.ws + WS_ROPE);
    const float QS = 0.125f * 1.4426950408889634f;
    float qg[16], kg[4];
#pragma unroll
    for (int i = 0; i < 16; ++i) qg[i] = P.q_norm_g[p * 64 + (lane & 3) * 16 + i];
#pragma unroll
    for (int i = 0; i < 4; ++i) kg[i] = P.k_norm_g[p * 64 + (lane & 15) * 4 + i];
    for (int row = gw; row < NTOK; row += nw) {
        const bool smp = row >= NPR; const int t = smp ? (row - NPR) & 1023 : row & 255; const int b = smp ? (row - NPR) >> 10 : row >> 8;
        bf16_t* pr = proj + (size_t)row * ODD_IN;
        const u32x4 r_q0 = *(const u32x4*)(pr + lane * 16), r_q1 = *(const u32x4*)(pr + lane * 16 + 8); const u32x2 r_k = *(const u32x2*)(pr + 1024 + lane * 4), r_v = *(const u32x2*)(pr + 1280 + lane * 4);
        { float x[16]; { float a[8], bq[8]; unpack8(r_q0, a); unpack8(r_q1, bq);
#pragma unroll
              for (int i = 0; i < 8; ++i) { x[i] = a[i]; x[8 + i] = bq[i]; } }
          float ss = 0.f;
#pragma unroll
          for (int i = 0; i < 16; ++i) ss += x[i] * x[i];
          ss = allred4(ss); const float rs = rsqrtf(ss * (1.0f / 64.0f) + 1e-6f);
#pragma unroll
          for (int i = 0; i < 16; ++i) x[i] *= rs * qg[i];
          if (smp) { const int pos = (lane & 2) ? (t & 63) : (t >> 6); const float* ct = rt + ((lane & 2) ? 512 : 0) + pos * 16; const float* st = rt + ((lane & 2) ? 1536 : 256) + pos * 16;
              const float sgn = (lane & 1) ? 1.0f : -1.0f;
#pragma unroll
              for (int i = 0; i < 16; ++i) { const float o = __builtin_bit_cast(float, __builtin_amdgcn_update_dpp(0, __builtin_bit_cast(int, x[i]), 0xB1, 0xf, 0xf, true)); x[i] = x[i] * ct[i] + sgn * o * st[i]; } }
          float o0[8], o1[8];
#pragma unroll
          for (int i = 0; i < 8; ++i) { o0[i] = x[i] * QS; o1[i] = x[8 + i] * QS; }
          *(u32x4*)(pr + lane * 16) = pack8(o0); *(u32x4*)(pr + lane * 16 + 8) = pack8(o1); }
        { const u32x2 kv = r_k; float x[4] = {bflo(kv.x), bfhi(kv.x), bflo(kv.y), bfhi(kv.y)};
          float ss = x[0] * x[0] + x[1] * x[1] + x[2] * x[2] + x[3] * x[3]; ss = allred16(ss); const float rs = rsqrtf(ss * (1.0f / 64.0f) + 1e-6f);
#pragma unroll
          for (int i = 0; i < 4; ++i) x[i] *= rs * kg[i];
          const int hk = lane >> 4, d0 = (lane & 15) * 4;
          if (!smp) { *(f32x4*)(P.out + OUT_CK + ((((size_t)b * 2 + p) * 4 + hk) * 256 + t) * 64 + d0) = (f32x4){x[0], x[1], x[2], x[3]};
              const u32x2 vv = r_v;
              *(f32x4*)(P.out + OUT_CV + ((((size_t)b * 2 + p) * 4 + hk) * 256 + t) * 64 + d0) = (f32x4){bflo(vv.x), bfhi(vv.x), bflo(vv.y), bfhi(vv.y)}; }
          else { const int l16 = lane & 15; const int pos = (l16 & 8) ? (t & 63) : (t >> 6); const float* ct = rt + ((l16 & 8) ? 512 : 0) + pos * 16 + (l16 & 3) * 4; const float* st = rt + ((l16 & 8) ? 1536 : 256) + pos * 16 + (l16 & 3) * 4;
              const float sgn = (l16 & 4) ? 1.0f : -1.0f;
#pragma unroll
              for (int i = 0; i < 4; ++i) { const float o = __builtin_bit_cast(float, __builtin_amdgcn_update_dpp(0, __builtin_bit_cast(int, x[i]), 0x124, 0xf, 0xf, true));
                  const float o2 = __builtin_bit_cast(float, __builtin_amdgcn_update_dpp(0, __builtin_bit_cast(int, x[i]), 0x12C, 0xf, 0xf, true));
                  const float partner = (l16 & 4) ? o2 : o; x[i] = x[i] * ct[i] + sgn * partner * st[i]; } }
          u32x2 w; w.x = cvt_pk_bf16(x[0], x[1]); w.y = cvt_pk_bf16(x[2], x[3]); *(u32x2*)(pr + 1024 + lane * 4) = w; }
    }
}

constexpr int AT_KS = 72;
constexpr int AT_KB = 64 * AT_KS * 2;
__device__ void attn_phase(const Params& P, LAS unsigned char* lds, int p) {
    const int tid = otid(), wave = __builtin_amdgcn_readfirstlane(tid >> 6), lane = tid & 63, l15 = lane & 15, q4 = lane >> 4;
    const bf16_t* proj = (const bf16_t*)(P.ws + WS_PROJ); bf16_t* mix = (bf16_t*)(P.ws + WS_HMIX);
    const int skey = tid >> 3, sds = tid & 7;
    for (int it = 0; it < 4; ++it) {
        const bool smp = it < 2; const int vcu = ((int)blockIdx.x & 7) * 32 + ((int)blockIdx.x >> 3); const int idx = vcu + 256 * (it & 1);
        int b, hk, qb; if (smp) { b = idx >> 6; hk = (idx >> 4) & 3; qb = idx & 15; } else { b = idx >> 4; hk = (idx >> 2) & 3; qb = idx & 3; }
        const int rowbase = smp ? NPR + b * 1024 : b * 256; const int ntiles = smp ? 24 : 4, ncache = smp ? 8 : 0;
        const int g = wave >> 1, tok0 = qb * 64 + (wave & 1) * 32, qh = hk * 4 + g;
        bf16x8 qf[2][2];
#pragma unroll
        for (int nt = 0; nt < 2; ++nt)
#pragma unroll
            for (int ks = 0; ks < 2; ++ks) qf[nt][ks] = *(const bf16x8*)(proj + (size_t)(rowbase + tok0 + nt * 16 + l15) * ODD_IN + qh * 64 + ks * 32 + q4 * 8);
        f32x4 O[4][2]; f32x4 lsumv[2] = {{0.f, 0.f, 0.f, 0.f}, {0.f, 0.f, 0.f, 0.f}};
#pragma unroll
        for (int mt = 0; mt < 4; ++mt)
#pragma unroll
            for (int nt = 0; nt < 2; ++nt) O[mt][nt] = (f32x4){0.f, 0.f, 0.f, 0.f};
        const float* ck = P.cache_k + (((size_t)b * 2 + p) * 4 + hk) * 512 * 64; const float* cv = P.cache_v + (((size_t)b * 2 + p) * 4 + hk) * 512 * 64;
        u32x4 ra0, ra1, ra2, ra3, rb0, rb1, rb2, rb3;
        ra1 = ra3 = rb1 = rb3 = (u32x4){0u, 0u, 0u, 0u};
        auto gload = [&](int j, u32x4& r0, u32x4& r1, u32x4& r2, u32x4& r3) {
            j = j < ntiles ? j : ntiles - 1;
            const bool cch = j < ncache;
            const char* kc = (const char*)(ck + (size_t)(j * 64 + skey) * 64 + sds * 8); const char* vc = (const char*)(cv + (size_t)(j * 64 + skey) * 64 + sds * 8);
            const char* kpj = (const char*)(proj + (size_t)(rowbase + (j - ncache) * 64 + skey) * ODD_IN + hk * 64 + sds * 8 + 1024);
            const char* p0 = cch ? kc : kpj; const char* p1 = cch ? kc + 16 : kpj; const char* p2 = cch ? vc : kpj + 512; const char* p3 = cch ? vc + 16 : kpj + 512;
            r0 = *(const u32x4*)p0; r1 = *(const u32x4*)p1; r2 = *(const u32x4*)p2; r3 = *(const u32x4*)p3;
        };
        auto lstore = [&](int j, int buf, const u32x4 r0, const u32x4 r1, const u32x4 r2, const u32x4 r3) {
            u32x4 kreg, vreg;
            if (j < ncache) {
                kreg.x = cvt_pk_bf16(__uint_as_float(r0.x), __uint_as_float(r0.y)); kreg.y = cvt_pk_bf16(__uint_as_float(r0.z), __uint_as_float(r0.w));
                kreg.z = cvt_pk_bf16(__uint_as_float(r1.x), __uint_as_float(r1.y)); kreg.w = cvt_pk_bf16(__uint_as_float(r1.z), __uint_as_float(r1.w));
                vreg.x = cvt_pk_bf16(__uint_as_float(r2.x), __uint_as_float(r2.y)); vreg.y = cvt_pk_bf16(__uint_as_float(r2.z), __uint_as_float(r2.w));
                vreg.z = cvt_pk_bf16(__uint_as_float(r3.x), __uint_as_float(r3.y)); vreg.w = cvt_pk_bf16(__uint_as_float(r3.z), __uint_as_float(r3.w));
            } else { kreg = r0; vreg = r2; }
            *(LAS u32x4*)(lds + buf * AT_KB + pg8::lds_byte(skey, sds * 8)) = kreg;
            LAS bf16_t* vt = (LAS bf16_t*)(lds + 2 * AT_KB + buf * AT_KB);
            vt[(sds * 8 + 0) * AT_KS + (skey ^ (sds << 3))] = (bf16_t)(vreg.x & 0xffff); vt[(sds * 8 + 1) * AT_KS + (skey ^ (sds << 3))] = (bf16_t)(vreg.x >> 16);
            vt[(sds * 8 + 2) * AT_KS + (skey ^ (sds << 3))] = (bf16_t)(vreg.y & 0xffff); vt[(sds * 8 + 3) * AT_KS + (skey ^ (sds << 3))] = (bf16_t)(vreg.y >> 16);
            vt[(sds * 8 + 4) * AT_KS + (skey ^ (sds << 3))] = (bf16_t)(vreg.z & 0xffff); vt[(sds * 8 + 5) * AT_KS + (skey ^ (sds << 3))] = (bf16_t)(vreg.z >> 16);
            vt[(sds * 8 + 6) * AT_KS + (skey ^ (sds << 3))] = (bf16_t)(vreg.w & 0xffff); vt[(sds * 8 + 7) * AT_KS + (skey ^ (sds << 3))] = (bf16_t)(vreg.w >> 16);
        };
        auto compute = [&](int buf) {
            const LAS unsigned char* kb = lds + buf * AT_KB; const LAS unsigned char* vb = lds + 2 * AT_KB + buf * AT_KB;
            f32x4 s[4][2];
#pragma unroll
            for (int mt = 0; mt < 4; ++mt) {
                s[mt][0] = (f32x4){0.f, 0.f, 0.f, 0.f}; s[mt][1] = (f32x4){0.f, 0.f, 0.f, 0.f};
#pragma unroll
                for (int ks = 0; ks < 2; ++ks) { const bf16x8 a = *(const LAS bf16x8*)(kb + pg8::lds_byte(mt * 16 + l15, ks * 32 + q4 * 8));
                    s[mt][0] = __builtin_amdgcn_mfma_f32_16x16x32_bf16(a, qf[0][ks], s[mt][0], 0, 0, 0);
                    s[mt][1] = __builtin_amdgcn_mfma_f32_16x16x32_bf16(a, qf[1][ks], s[mt][1], 0, 0, 0); }
            }
            bf16x8 pf[2][2];
#pragma unroll
            for (int nt = 0; nt < 2; ++nt)
#pragma unroll
                for (int kp = 0; kp < 2; ++kp) { float e[8];
#pragma unroll
                    for (int i = 0; i < 4; ++i) { e[i] = __builtin_amdgcn_exp2f(s[2 * kp][nt][i]); e[4 + i] = __builtin_amdgcn_exp2f(s[2 * kp + 1][nt][i]); }
                    u32x4 w; w.x = cvt_pk_bf16(e[0], e[1]); w.y = cvt_pk_bf16(e[2], e[3]); w.z = cvt_pk_bf16(e[4], e[5]); w.w = cvt_pk_bf16(e[6], e[7]);
                    pf[nt][kp] = __builtin_bit_cast(bf16x8, w); }
            { const u32x4 ones_ = {0x3F803F80u, 0x3F803F80u, 0x3F803F80u, 0x3F803F80u}; const bf16x8 ones = __builtin_bit_cast(bf16x8, ones_);
#pragma unroll
              for (int nt = 0; nt < 2; ++nt)
#pragma unroll
                  for (int kp = 0; kp < 2; ++kp) lsumv[nt] = __builtin_amdgcn_mfma_f32_16x16x32_bf16(ones, pf[nt][kp], lsumv[nt], 0, 0, 0); }
#pragma unroll
            for (int mt = 0; mt < 4; ++mt)
#pragma unroll
                for (int kp = 0; kp < 2; ++kp) { const int vsw = ((2 * mt + (l15 >> 3)) & 7) << 3; const u32x2 a0 = *(const LAS u32x2*)(vb + ((mt * 16 + l15) * AT_KS + ((kp * 32 + q4 * 4) ^ vsw)) * 2), a1 = *(const LAS u32x2*)(vb + ((mt * 16 + l15) * AT_KS + ((kp * 32 + 16 + q4 * 4) ^ vsw)) * 2);
                    const u32x4 au = {a0.x, a0.y, a1.x, a1.y}; const bf16x8 a = __builtin_bit_cast(bf16x8, au);
                    O[mt][0] = __builtin_amdgcn_mfma_f32_16x16x32_bf16(a, pf[0][kp], O[mt][0], 0, 0, 0);
                    O[mt][1] = __builtin_amdgcn_mfma_f32_16x16x32_bf16(a, pf[1][kp], O[mt][1], 0, 0, 0); }
        };
#define AT_BAR() do { asm volatile("s_waitcnt lgkmcnt(0)" ::: "memory"); __builtin_amdgcn_s_barrier(); asm volatile("" ::: "memory"); } while (0)
        __syncthreads();
        gload(0, ra0, ra1, ra2, ra3); lstore(0, 0, ra0, ra1, ra2, ra3); gload(1, rb0, rb1, rb2, rb3);
        AT_BAR();
        for (int j = 0; j < ntiles; j += 2) {
            gload(j + 2, ra0, ra1, ra2, ra3);
            compute(0);
            lstore(j + 1, 1, rb0, rb1, rb2, rb3);
            AT_BAR();
            gload(j + 3, rb0, rb1, rb2, rb3);
            compute(1);
            if (j + 2 < ntiles) lstore(j + 2, 0, ra0, ra1, ra2, ra3);
            AT_BAR();
        }
#undef AT_BAR
#pragma unroll
        for (int nt = 0; nt < 2; ++nt) {
            const float inv = 1.0f / lsumv[nt][0];
            const size_t row = (size_t)(rowbase + tok0 + nt * 16 + l15);
            u32x2 gvv[4];
#pragma unroll
            for (int mt = 0; mt < 4; ++mt) gvv[mt] = *(const u32x2*)(proj + row * ODD_IN + 1536 + qh * 64 + mt * 16 + q4 * 4);
#pragma unroll
            for (int mt = 0; mt < 4; ++mt) { const int col = qh * 64 + mt * 16 + q4 * 4;
                const u32x2 gv = gvv[mt];
                const float o0 = O[mt][nt][0] * inv * siluf_(bflo(gv.x)), o1 = O[mt][nt][1] * inv * siluf_(bfhi(gv.x)), o2 = O[mt][nt][2] * inv * siluf_(bflo(gv.y)), o3 = O[mt][nt][3] * inv * siluf_(bfhi(gv.y));
                u32x2 w; w.x = cvt_pk_bf16(o0, o1); w.y = cvt_pk_bf16(o2, o3); *(u32x2*)(mix + row * DM + col) = w; }
        }
    }
}

__global__ void __launch_bounds__(NTHREADS, 2) fwd_megakernel(Params P) {
    extern __shared__ __attribute__((aligned(16))) unsigned char lds_raw[];
    LAS unsigned char* lds = (LAS unsigned char*)lds_raw;
    cg::grid_group grid = cg::this_grid();
    const int G = gridDim.x;
    unsigned* barw = (unsigned*)(P.ws + WS_BAR);
    volatile LAS unsigned* xst = (volatile LAS unsigned*)(lds + 131072);
    if (threadIdx.x < 4) xst[threadIdx.x] = 0u;
    __syncthreads();
    const XcdBarrier xbar = xcd_barrier_post(barw, xst);
    if (P.out == nullptr) grid.sync();
#define GSYNC() xcd_barrier(xbar)
#ifndef SKIP_P0
    p0_phase(P, lds);
#endif
    GSYNC();
#pragma nounroll
    for (int L = 0; L < 4; ++L) {
#ifdef DBL_SYNC
        for (int q = 0; q < 5; ++q) GSYNC();
#endif
        const int p = L >> 1; const bool even = (L & 1) == 0;
        if (L == 0) { modulate_phase(P, 0); GSYNC(); }
        {
            const int N = even ? EVEN_IN : ODD_IN;
            const bf16_t* Bt = even ? (const bf16_t*)(P.ws + WS_WINE) + (size_t)p * EVEN_IN * 1024 : (const bf16_t*)(P.ws + WS_WINO) + (size_t)p * ODD_IN * 1024;
            pg8::Gemm g{(const bf16_t*)(P.ws + WS_HMIX), Bt, NTOK, N, 1024}; pg8::StaticOrder S; S.init(NTOK, N, G, (int)blockIdx.x);
            pg8::EpiBf16 E{(bf16_t*)(P.ws + WS_PROJ), N};
#ifndef SKIP_G1
            pg8::gemm_phase<pg8::EpiBf16>(lds, g, S, E);
#endif
            { const int bx = (int)blockIdx.x;
              if (L == 0 && bx >= 64) { tr_range(P, lds, 2176, 2432, bx - 64, G - 64); tr_range(P, lds, 2688, 3328, bx - 64, G - 64); tr_range(P, lds, 3968, 4224, bx - 64, G - 64); }
              else if (L == 1 && bx >= 128) tr_range(P, lds, 1088, 2176, bx - 128, G - 128);
              else if (L == 2 && bx >= 64) { tr_range(P, lds, 2432, 2688, bx - 64, G - 64); tr_range(P, lds, 3328, 3968, bx - 64, G - 64); tr_range(P, lds, 4224, 4480, bx - 64, G - 64); } }
#ifdef DBL_G1
            GSYNC(); pg8::gemm_phase<pg8::EpiBf16>(lds, g, S, E);
#endif
        }
        GSYNC();
        if (even) {
#ifndef SKIP_SCAN
            scan_phase(P, lds, p);
#endif
#ifdef DBL_SCAN
            GSYNC(); scan_phase(P, lds, p);
#endif
            GSYNC();
#ifndef SKIP_POST
            even_post_phase(P, p);
#endif
#ifdef DBL_MISC
            GSYNC(); even_post_phase(P, p);
#endif
        } else {
#ifndef SKIP_QK
            qknorm_phase(P, p);
#endif
            GSYNC();
#ifndef SKIP_ATT
            attn_phase(P, lds, p);
#endif
#ifdef DBL_ATT
            GSYNC(); attn_phase(P, lds, p);
#endif
        }
        GSYNC();
        {
            const bf16_t* Bt = even ? (const bf16_t*)(P.ws + WS_WOUTE) + (size_t)p * 1024 * 1024 : (const bf16_t*)(P.ws + WS_WOUTO) + (size_t)p * 1024 * 1024;
            pg8::Gemm g{(const bf16_t*)(P.ws + WS_HMIX), Bt, NTOK, 1024, 1024}; pg8::StaticOrder S; S.init(NTOK, 1024, G, (int)blockIdx.x);
            pg8::EpiFuse E{L == 0 ? P.x_prompt : P.out, L == 0 ? P.x_sample : P.out + (size_t)NPR * DM, P.out, (const float*)(P.ws + WS_MOD) + (size_t)L * 9 * 3072,
                           L < 3 ? (bf16_t*)(P.ws + WS_HMIX) : nullptr, P.norm_g + (L < 3 ? L + 1 : 0) * 1024, (const float*)(P.ws + WS_MOD) + (size_t)(L < 3 ? L + 1 : 0) * 9 * 3072,
                           P.final_g, (float*)(P.ws + WS_XSLOT), (unsigned*)(P.ws + WS_XCNT) + (size_t)L * 64 * 64};
            pg8::gemm_phase<pg8::EpiFuse>(lds, g, S, E);
        }
        if (L < 3) GSYNC();
    }
}

extern "C" void kernel_launch(void* const* d_in, const int* in_sizes, int n_in, void* d_out, int out_size, void* d_ws, size_t ws_size, hipStream_t stream) {
    static int grid = 0;
    if (grid == 0) {
        if (n_in != 29 || ws_size < WS_END) { fprintf(stderr, "kernel_launch: unexpected n_in %d or ws_size %zu (< %zu)\n", n_in, ws_size, (size_t)WS_END); grid = -1; return; }
        int dev = 0, cus = 0, per_cu = 0;
        hipGetDevice(&dev); hipDeviceGetAttribute(&cus, hipDeviceAttributeMultiprocessorCount, dev);
        if (hipFuncSetAttribute((const void*)fwd_megakernel, hipFuncAttributeMaxDynamicSharedMemorySize, LDS_BYTES) != hipSuccess) { fprintf(stderr, "hipFuncSetAttribute failed\n"); grid = -1; return; }
        hipOccupancyMaxActiveBlocksPerMultiprocessor(&per_cu, (const void*)fwd_megakernel, NTHREADS, LDS_BYTES);
        if (per_cu < 1) { fprintf(stderr, "occupancy query says %d blocks per CU\n", per_cu); per_cu = 1; }
        (void)hipGetLastError();
        grid = cus;
    }
    if (grid < 0) return;
    if (hipMemsetAsync((char*)d_ws + WS_BAR, 0, 16384 + 4 * 64 * 256, stream) != hipSuccess) { fprintf(stderr, "hipMemsetAsync of the barrier words failed\n"); return; }
    Params p{};
    const float** pp = (const float**)&p;
    for (int i = 0; i < 29; ++i) pp[i] = (const float*)d_in[i];
    p.out = (float*)d_out; p.ws = (unsigned char*)d_ws;
    void* args[] = {&p};
    hipError_t e = hipLaunchCooperativeKernel((const void*)fwd_megakernel, dim3(grid), dim3(NTHREADS), args, LDS_BYTES, stream);
    if (e != hipSuccess) fprintf(stderr, "cooperative launch failed: %s (grid %d)\n", hipGetErrorString(e), grid);
}
```
